# Optimizing an MI355X kernel written in HIP

```python
import math
import jax, jax.numpy as jnp
from jax import lax
import numpy as np

D_MODEL = 2048
BATCH = 1
SEQ = 8192
DEPTH = 1
DEC_BATCH = 1
DEC_SEQ = 16384
PAST_LEN = 128

D_MIX = D_MODEL
D_MLSTM = D_MIX // 2
D_S5 = D_MIX - D_MLSTM
MLSTM_HEADS = 8
MLSTM_HEAD_DIM = D_MLSTM // MLSTM_HEADS
MLSTM_CHUNK = 128
CONV_WIDTH = 3
S5_GROUP_CH = 16
S5_GROUPS = D_S5 // S5_GROUP_CH
S5_STATE = 64
D_FF = 5632
N_GATES = 4 * MLSTM_HEADS
D_IN = 4 * D_MLSTM + N_GATES + D_S5
EPS = 1e-6
M_INIT = -1e30

kernel_name = "hybrid_mlstm_s5_macaron_encoder"


def rmsnorm(x, w):
    xf = x.astype(jnp.float32)
    y = xf * lax.rsqrt(jnp.mean(xf * xf, axis=-1, keepdims=True) + EPS)
    return (y * w.astype(jnp.float32)).astype(x.dtype)


def swiglu_ffn(x, w_gate, w_up, w_down):
    return (jax.nn.silu(x @ w_gate) * (x @ w_up)) @ w_down


def centred_dwconv(x, w, b):
    pad = (CONV_WIDTH - 1) // 2
    L = x.shape[1]
    xp = jnp.pad(x, ((0, 0), (pad, pad), (0, 0)))
    out = xp[:, 0:L] * w[0]
    for j in range(1, CONV_WIDTH):
        out = out + xp[:, j:j + L] * w[j]
    return out + b


def mlstm_chunkwise(q, k, v, ig, lf):
    Bb, H, L, dh = q.shape
    T = MLSTM_CHUNK
    nc = L // T
    qc = q.reshape(Bb, H, nc, T, dh).transpose(2, 0, 1, 3, 4)
    kc = k.reshape(Bb, H, nc, T, dh).transpose(2, 0, 1, 3, 4)
    vc = v.reshape(Bb, H, nc, T, dh).transpose(2, 0, 1, 3, 4)
    ic = ig.reshape(Bb, H, nc, T).transpose(2, 0, 1, 3)
    fc = lf.reshape(Bb, H, nc, T).transpose(2, 0, 1, 3)
    tril = jnp.tril(jnp.ones((T, T), dtype=bool))

    def step(carry, inp):
        C, n, m = carry
        qb, kb, vb, ib, fb = inp
        b = jnp.cumsum(fb, axis=-1)
        dmat = b[..., :, None] - b[..., None, :] + ib[..., None, :]
        dmat = jnp.where(tril, dmat, -jnp.inf)
        inter = b + m[..., None]
        m_t = jnp.maximum(jnp.max(dmat, axis=-1), inter)
        w = jnp.exp(dmat - m_t[..., None])
        s_inter = jnp.exp(inter - m_t)
        s = jnp.einsum('bhtd,bhsd->bhts', qb, kb) * w
        num = jnp.einsum('bhts,bhsd->bhtd', s, vb) + s_inter[..., None] * jnp.einsum('bhed,bhtd->bhte', C, qb)
        den = jnp.sum(s, axis=-1) + s_inter * jnp.einsum('bhd,bhtd->bht', n, qb)
        h = num / jnp.maximum(jnp.abs(den), jnp.exp(-m_t))[..., None]
        bT = b[..., -1]
        wk = bT[..., None] - b + ib
        m_new = jnp.maximum(bT + m, jnp.max(wk, axis=-1))
        sc = jnp.exp(bT + m - m_new)
        wkk = jnp.exp(wk - m_new[..., None])
        C_new = sc[..., None, None] * C + jnp.einsum('bhs,bhse,bhsd->bhed', wkk, vb, kb)
        n_new = sc[..., None] * n + jnp.einsum('bhs,bhsd->bhd', wkk, kb)
        return (C_new, n_new, m_new), h

    init = (jnp.zeros((Bb, H, dh, dh), jnp.float32),
            jnp.zeros((Bb, H, dh), jnp.float32),
            jnp.full((Bb, H), M_INIT, jnp.float32))
    _, h = lax.scan(step, init, (qc, kc, vc, ic, fc))
    return h.transpose(1, 2, 0, 3, 4).reshape(Bb, H, L, dh)


def mlstm_group(q_in, k_in, v_in, o_in, gates, conv_w, conv_b, b_igate, b_fgate, norm_w):
    Bb, L, _ = q_in.shape
    H, dh = MLSTM_HEADS, MLSTM_HEAD_DIM
    qk = jax.nn.silu(centred_dwconv(jnp.concatenate([q_in, k_in], axis=-1), conv_w, conv_b)).astype(jnp.float32)

    def heads(a):
        return a.reshape(Bb, L, H, dh).transpose(0, 2, 1, 3)

    q = heads(qk[..., :D_MLSTM]) * (dh ** -0.5)
    k = heads(qk[..., D_MLSTM:])
    v = heads(v_in.astype(jnp.float32))
    g = gates.astype(jnp.float32).reshape(Bb, L, 4, H)
    ig = (g[:, :, 0:2] + b_igate.astype(jnp.float32)).transpose(0, 2, 3, 1)
    lf = jax.nn.log_sigmoid(g[:, :, 2:4] + b_fgate.astype(jnp.float32)).transpose(0, 2, 3, 1)
    h_fwd = mlstm_chunkwise(q, k, v, ig[:, 0], lf[:, 0])
    flip = lambda a: jnp.flip(a, axis=2)
    h_bwd = flip(mlstm_chunkwise(flip(q), flip(k), flip(v), flip(ig[:, 1]), flip(lf[:, 1])))
    h = h_fwd + h_bwd
    mu = jnp.mean(h, axis=-1, keepdims=True)
    var = jnp.mean(jnp.square(h - mu), axis=-1, keepdims=True)
    hn = ((h - mu) * lax.rsqrt(var + EPS)).transpose(0, 2, 1, 3).reshape(Bb, L, D_MLSTM)
    return hn * norm_w.astype(jnp.float32) * jax.nn.sigmoid(o_in.astype(jnp.float32))


def _ssm_combine(e1, e2):
    a1, b1 = e1
    a2, b2 = e2
    return a2 * a1, a2 * b1 + b2


def s5_direction(ug, a_re, a_im, log_dt, b_re, b_im, c_re, c_im, reverse):
    f32 = jnp.float32
    lam = lax.complex(a_re.astype(f32), a_im.astype(f32))
    dt = jnp.exp(log_dt.astype(f32))[:, None]
    lam_bar = jnp.exp(lam * dt)
    b_mat = lax.complex(b_re.astype(f32), b_im.astype(f32))
    b_bar = ((lam_bar - 1.0) / lam)[..., None] * b_mat
    bu = jnp.einsum('gpc,blgc->blgp', b_bar, ug.astype(jnp.complex64))
    a = jnp.broadcast_to(lam_bar, bu.shape)
    _, xs = lax.associative_scan(_ssm_combine, (a, bu), axis=1, reverse=reverse)
    c_mat = lax.complex(c_re.astype(f32), c_im.astype(f32))
    return jnp.real(jnp.einsum('gcp,blgp->blgc', c_mat, xs))


def s5_group(u, a_re, a_im, log_dt, b_re, b_im, c_re, c_im, d_skip, w_glu):
    Bb, L, _ = u.shape
    uf = u.astype(jnp.float32)
    ug = uf.reshape(Bb, L, S5_GROUPS, S5_GROUP_CH)
    y_f = s5_direction(ug, a_re[0], a_im[0], log_dt[0], b_re[0], b_im[0], c_re[0], c_im[0], False)
    y_b = s5_direction(ug, a_re[1], a_im[1], log_dt[1], b_re[1], b_im[1], c_re[1], c_im[1], True)
    y = (y_f + y_b).reshape(Bb, L, D_S5) + d_skip.astype(jnp.float32) * uf
    ab = jax.nn.gelu(y) @ w_glu.astype(jnp.float32)
    return ab[..., :D_S5] * jax.nn.sigmoid(ab[..., D_S5:])


def setup_inputs(seed: int = 0) -> dict:
    key = jax.random.key(seed)
    ks = iter(jax.random.split(key, 40))
    f32 = jnp.float32
    nrm = lambda shape, scale: jax.random.normal(next(ks), shape, f32) * scale
    gain = lambda shape: 1.0 + nrm(shape, 0.01)
    H, G, P, GC = MLSTM_HEADS, S5_GROUPS, S5_STATE, S5_GROUP_CH
    fbias = jnp.broadcast_to(jnp.linspace(3.0, 6.0, H, dtype=f32), (DEPTH, 2, H)) + nrm((DEPTH, 2, H), 0.1)
    a_im0 = jnp.broadcast_to(math.pi * jnp.arange(P, dtype=f32), (DEPTH, 2, G, P))
    return {
        "x_prompt": nrm((BATCH, SEQ, D_MODEL), 1.0),
        "x_sample": nrm((DEC_BATCH, DEC_SEQ, D_MODEL), 1.0),
        "norm_ffn1": gain((DEPTH, D_MODEL)),
        "ffn1_w_gate": nrm((DEPTH, D_MODEL, D_FF), D_MODEL ** -0.5),
        "ffn1_w_up": nrm((DEPTH, D_MODEL, D_FF), D_MODEL ** -0.5),
        "ffn1_w_down": nrm((DEPTH, D_FF, D_MODEL), D_FF ** -0.5),
        "norm_mix": gain((DEPTH, D_MODEL)),
        "w_in": nrm((DEPTH, D_MODEL, D_IN), D_MODEL ** -0.5),
        "conv_w": nrm((DEPTH, CONV_WIDTH, 2 * D_MLSTM), CONV_WIDTH ** -0.5),
        "conv_b": nrm((DEPTH, 2 * D_MLSTM), 0.01),
        "b_igate": nrm((DEPTH, 2, H), 0.1),
        "b_fgate": fbias,
        "mlstm_norm_w": gain((DEPTH, D_MLSTM)),
        "s5_a_re": -0.5 + nrm((DEPTH, 2, G, P), 0.01),
        "s5_a_im": a_im0 + nrm((DEPTH, 2, G, P), 0.01),
        "s5_log_dt": jax.random.uniform(next(ks), (DEPTH, 2, G), f32, math.log(1e-3), math.log(1e-1)),
        "s5_b_re": nrm((DEPTH, 2, G, P, GC), (2 * GC) ** -0.5),
        "s5_b_im": nrm((DEPTH, 2, G, P, GC), (2 * GC) ** -0.5),
        "s5_c_re": nrm((DEPTH, 2, G, GC, P), (2 * P) ** -0.5),
        "s5_c_im": nrm((DEPTH, 2, G, GC, P), (2 * P) ** -0.5),
        "s5_d": nrm((DEPTH, D_S5), 1.0),
        "s5_w_glu": nrm((DEPTH, D_S5, 2 * D_S5), D_S5 ** -0.5),
        "w_out": nrm((DEPTH, D_MIX, D_MODEL), D_MIX ** -0.5),
        "norm_ffn2": gain((DEPTH, D_MODEL)),
        "ffn2_w_gate": nrm((DEPTH, D_MODEL, D_FF), D_MODEL ** -0.5),
        "ffn2_w_up": nrm((DEPTH, D_MODEL, D_FF), D_MODEL ** -0.5),
        "ffn2_w_down": nrm((DEPTH, D_FF, D_MODEL), D_FF ** -0.5),
        "norm_final": gain((D_MODEL,)),
    }


def reference(x_prompt, x_sample, norm_ffn1, ffn1_w_gate, ffn1_w_up, ffn1_w_down, norm_mix, w_in, conv_w, conv_b,
              b_igate, b_fgate, mlstm_norm_w, s5_a_re, s5_a_im, s5_log_dt, s5_b_re, s5_b_im, s5_c_re, s5_c_im,
              s5_d, s5_w_glu, w_out, norm_ffn2, ffn2_w_gate, ffn2_w_up, ffn2_w_down, norm_final):

    def encode(x):
        for l in range(DEPTH):
            x = x + 0.5 * swiglu_ffn(rmsnorm(x, norm_ffn1[l]), ffn1_w_gate[l], ffn1_w_up[l], ffn1_w_down[l])
            z = rmsnorm(x, norm_mix[l]) @ w_in[l]
            q_in = z[..., 0:D_MLSTM]
            k_in = z[..., D_MLSTM:2 * D_MLSTM]
            v_in = z[..., 2 * D_MLSTM:3 * D_MLSTM]
            o_in = z[..., 3 * D_MLSTM:4 * D_MLSTM]
            gates = z[..., 4 * D_MLSTM:4 * D_MLSTM + N_GATES]
            u = z[..., 4 * D_MLSTM + N_GATES:]
            h_m = mlstm_group(q_in, k_in, v_in, o_in, gates, conv_w[l], conv_b[l], b_igate[l], b_fgate[l],
                              mlstm_norm_w[l])
            h_s = s5_group(u, s5_a_re[l], s5_a_im[l], s5_log_dt[l], s5_b_re[l], s5_b_im[l], s5_c_re[l], s5_c_im[l],
                           s5_d[l], s5_w_glu[l])
            mix = jnp.concatenate([h_m, h_s], axis=-1).astype(x.dtype) @ w_out[l]
            x = x + mix
            x = x + 0.5 * swiglu_ffn(rmsnorm(x, norm_ffn2[l]), ffn2_w_gate[l], ffn2_w_up[l], ffn2_w_down[l])
        return rmsnorm(x, norm_final)

    y_prompt = encode(x_prompt)
    y_sample = encode(x_sample)
    return (y_prompt, y_sample)
```

```cpp
#include <hip/hip_runtime.h>
#include <hip/hip_cooperative_groups.h>
#include <cstdio>
#include <cstdint>
namespace cg = cooperative_groups;

#define LAS __attribute__((address_space(3)))
typedef unsigned short bf16_t;
typedef short bf16x8 __attribute__((ext_vector_type(8)));
typedef float f32x4 __attribute__((ext_vector_type(4)));
typedef unsigned u32x4 __attribute__((ext_vector_type(4)));
typedef unsigned u32x2 __attribute__((ext_vector_type(2)));

constexpr int MROWS = 24576, SEQ_P = 8192, DM = 2048, DFF = 5632, DMH = 1024, NHEAD = 8, DH = 128;
constexpr int LDZ = 4096;
constexpr int NZ = 5376;
constexpr int S5NCB = 48;
constexpr int LDZ_OLD_UNUSED = 0;
constexpr int D_IN = 5152;
constexpr int NCH = MROWS / 128;
constexpr int S5T = 32, S5NC = MROWS / S5T;
constexpr float EPS = 1e-6f;

constexpr size_t MiB = 1u << 20;
constexpr size_t WS_UG = 322 * MiB;
constexpr size_t WS_WIN = 1 * MiB, WS_WGLU = 22 * MiB, WS_WOUT = 26 * MiB, WS_XN = 34 * MiB, WS_BIG = 130 * MiB;
constexpr size_t WS_WAD = 394 * MiB, WS_WAGU = 416 * MiB;
constexpr size_t WS_GATES = 382 * MiB, WS_S5E = 385 * MiB, WS_S5W1 = 433 * MiB, WS_S5W3 = 449 * MiB;
constexpr size_t WS_ST = 385 * MiB, WS_NST = 481 * MiB, WS_DEC = 483 * MiB, WS_END = 512 * MiB;
constexpr size_t WS_SS1 = 131072;
constexpr size_t WS_SS3 = 262144;
constexpr size_t WS_SS2 = 393216;
constexpr size_t WS_ZERO_BYTES = 524288;
constexpr size_t WS_XN2 = 130 * MiB, WS_H2 = 226 * MiB, WS_WAGU2 = 1 * MiB, WS_WAD2 = 45 * MiB;

constexpr int LDS_BYTES = 147456;

__device__ __forceinline__ unsigned f2bf(float f) { return (__builtin_bit_cast(unsigned, f) + 0x8000u) >> 16; }
__device__ __forceinline__ unsigned pk2(float lo, float hi) {
    const unsigned ra = __builtin_bit_cast(unsigned, lo) + 0x8000u, rb = __builtin_bit_cast(unsigned, hi) + 0x8000u;
    return __builtin_amdgcn_perm(rb, ra, 0x07060302u);
}
__device__ __forceinline__ float bflo(unsigned v) { return __uint_as_float(v << 16); }
__device__ __forceinline__ float bfhi(unsigned v) { return __uint_as_float(v & 0xffff0000u); }
__device__ __forceinline__ float bf2f(bf16_t v) { return __uint_as_float(((unsigned)v) << 16); }
__device__ __forceinline__ float sigmoid_f(float x) { return __builtin_amdgcn_rcpf(1.f + __expf(-x)); }
__device__ __forceinline__ float silu_f(float x) { return x * sigmoid_f(x); }
__device__ __forceinline__ float logsigmoid_f(float x) { return fminf(x, 0.f) - log1pf(__expf(-fabsf(x))); }
__device__ __forceinline__ float gelu_tanh_f(float x) { const float u = 0.7978845608028654f * (x + 0.044715f * x * x * x); return x * sigmoid_f(2.f * u); }
__device__ __forceinline__ float wave_sum(float v) {
#pragma unroll
    for (int o = 1; o < 64; o <<= 1) v += __shfl_xor(v, o);
    return v;
}
#define MFMA16(a, b, c) __builtin_amdgcn_mfma_f32_16x16x32_bf16((a), (b), (c), 0, 0, 0)

namespace pg8 {
constexpr int BM = 256, BK = 64, HALF = 128, HTB = HALF * BK * 2, STAGE_BYTES = 8 * HTB, NXCD = 8, WGM = 8;
__host__ __device__ __forceinline__ int lds_byte(int r, int c) { const int st = (r >> 4) * 2 + (c >> 5), rr = r & 15, cc = c & 31, ob = rr * 64 + cc * 2; return st * 1024 + (ob ^ (((ob >> 9) & 1) << 5)); }
__host__ __device__ __forceinline__ void stage_rc(int b, int& R, int& C) { const int st = b / 1024, sb = b % 1024, swz = sb ^ (((sb >> 9) & 1) << 5); R = (st >> 1) * 16 + swz / 64; C = (st & 1) * 32 + (swz % 64) / 2; }
__host__ __device__ __forceinline__ int perm32(int rho) { const int n = rho >> 4, i = rho & 15; return 8 * (i >> 2) + 4 * n + (i & 3); }

struct Unit { int pm, pn; };
struct Gemm { const bf16_t* A; const bf16_t* Bt; int M, N, K, lda; };

struct StaticOrder {
    int nM, nN, nwg, G, c;
    __device__ void init(int M, int N, int G_, int c_) { nM = M / BM; nN = N / BM; nwg = nM * nN; G = G_; c = c_; }
    __device__ bool next(int i, Unit& u) const {
        const long L = (long)i * G + c; if (L >= nwg) return false;
        int wgid = (int)L; { const int q = nwg / NXCD, r = nwg % NXCD, xcd = wgid % NXCD, off = wgid / NXCD; wgid = (xcd < r ? xcd * (q + 1) : r * (q + 1) + (xcd - r) * q) + off; }
        const int nig = WGM * nN, gid = wgid / nig, fm = gid * WGM, gsz = (nM - fm) < WGM ? (nM - fm) : WGM;
        u.pm = fm + ((wgid % nig) % gsz); u.pn = (wgid % nig) / gsz; return true;
    }
};

struct EpiSwiglu {
    static constexpr bool PERM = true;
    bf16_t* O; int ldc; int glu; const float* ss;
    __device__ __forceinline__ void operator()(const f32x4 (&acc)[2][2][4][2], const Unit& u, int wr, int wc, int fr, int fq) const {
        const int row0 = u.pm * BM + wr * 64 + fr, col0 = u.pn * HALF + wc * 32 + 8 * fq;
#pragma unroll
        for (int ai = 0; ai < 2; ++ai)
#pragma unroll
            for (int m = 0; m < 4; ++m) {
                bf16_t* rowp = O + (size_t)(row0 + ai * HALF + m * 16) * ldc + col0;
                const float rs = ss ? rsqrtf(ss[row0 + ai * HALF + m * 16] * (1.f / DM) + EPS) : 1.f;
                const f32x4 g0 = acc[ai][0][m][0] * rs, g1 = acc[ai][0][m][1] * rs, u0 = acc[ai][1][m][0] * rs, u1 = acc[ai][1][m][1] * rs;
                float r[8];
#pragma unroll
                for (int i = 0; i < 4; ++i) {
                    r[i] = glu ? g0[i] * sigmoid_f(u0[i]) : silu_f(g0[i]) * u0[i];
                    r[4 + i] = glu ? g1[i] * sigmoid_f(u1[i]) : silu_f(g1[i]) * u1[i];
                }
                u32x4 w; w.x = pk2(r[0], r[1]); w.y = pk2(r[2], r[3]); w.z = pk2(r[4], r[5]); w.w = pk2(r[6], r[7]);
                *(u32x4*)rowp = w;
            }
    }
};
struct EpiResid {
    static constexpr bool PERM = false;
    const float* resA; const float* resB; float* out; int ldc; float scale; bf16_t* xn; const float* wn; float* ss;
    __device__ __forceinline__ void operator()(const f32x4 (&acc)[2][2][4][2], const Unit& u, int wr, int wc, int fr, int fq) const {
        const int row0 = u.pm * BM + wr * 64 + fr, col0 = u.pn * BM + wc * 32 + 4 * fq;
        const float* rbase = (u.pm * BM < SEQ_P) ? resA : (resB - (size_t)SEQ_P * ldc);
        f32x4 wv[2][2];
        if (xn) {
#pragma unroll
            for (int bj = 0; bj < 2; ++bj)
#pragma unroll
                for (int n = 0; n < 2; ++n) wv[bj][n] = *(const f32x4*)(wn + col0 + bj * HALF + n * 16);
        }
#pragma unroll
        for (int ai = 0; ai < 2; ++ai)
#pragma unroll
            for (int m = 0; m < 4; ++m) {
                const int row = row0 + ai * HALF + m * 16;
                const size_t off = (size_t)row * ldc + col0;
                float q = 0.f;
#pragma unroll
                for (int bj = 0; bj < 2; ++bj)
#pragma unroll
                    for (int n = 0; n < 2; ++n) {
                        const f32x4 rv = *(const f32x4*)(rbase + off + bj * HALF + n * 16);
                        const f32x4 v = rv + acc[ai][bj][m][n] * scale;
                        if (out) *(f32x4*)(out + off + bj * HALF + n * 16) = v;
                        if (xn) { q += (v.x * v.x + v.y * v.y) + (v.z * v.z + v.w * v.w); const f32x4 o = v * wv[bj][n];
                            u32x2 p; p.x = pk2(o.x, o.y); p.y = pk2(o.z, o.w); *(u32x2*)(xn + off + bj * HALF + n * 16) = p; }
                    }
                if (xn) { q += __shfl_xor(q, 16); q += __shfl_xor(q, 32); if (fq == 0) (void)__hip_atomic_fetch_add(ss + row, q, __ATOMIC_RELAXED, __HIP_MEMORY_SCOPE_AGENT); }
            }
    }
};
struct EpiZ {
    static constexpr bool PERM = true;
    bf16_t* O; int ldc; float* gates; int gate_pn; const float* ss; bf16_t* ug;
    __device__ __forceinline__ void operator()(const f32x4 (&acc)[2][2][4][2], const Unit& u, int wr, int wc, int fr, int fq) const {
        const int row0 = u.pm * BM + wr * 64 + fr;
        const int kind = (u.pn == gate_pn) ? 2 : (u.pn >= 16 ? 1 : 0);
        if (kind == 2 && wc != 0) return;
#pragma unroll
        for (int ai = 0; ai < 2; ++ai)
#pragma unroll
            for (int m = 0; m < 4; ++m) {
                const int row = row0 + ai * HALF + m * 16;
                const float rs = rsqrtf(ss[row] * (1.f / DM) + EPS);
                if (kind == 2) {
                    float* gp = gates + (size_t)row * 32 + 8 * fq;
                    *(f32x4*)gp = acc[ai][0][m][0] * rs; *(f32x4*)(gp + 4) = acc[ai][0][m][1] * rs;
                } else {
#pragma unroll
                    for (int bj = 0; bj < 2; ++bj) {
                        const f32x4 v0 = acc[ai][bj][m][0] * rs, v1 = acc[ai][bj][m][1] * rs;
                        u32x4 w; w.x = pk2(v0[0], v0[1]); w.y = pk2(v0[2], v0[3]); w.z = pk2(v1[0], v1[1]); w.w = pk2(v1[2], v1[3]);
                        bf16_t* dst;
                        if (kind == 1) { const int chunk = row >> 5, j = row & 31, ucol = (u.pn - 16) * BM + bj * HALF + wc * 32 + 8 * fq, g = ucol >> 4, half = (ucol >> 3) & 1;
                            dst = ug + ((((size_t)(g * S5NCB + (chunk >> 4)) * 32 + j) * 16 + (chunk & 15)) * 16 + half * 8); }
                        else dst = O + (size_t)row * ldc + u.pn * BM + bj * HALF + wc * 32 + 8 * fq;
                        *(u32x4*)dst = w;
                    }
                }
            }
    }
};

template <class Epi, bool ALIGN_EPI>
__device__ __forceinline__ void gemm_phase(LAS unsigned char* lds, const Gemm g, const StaticOrder& S, const Epi& E) {
    int tid_ = threadIdx.x; asm volatile("" : "+v"(tid_));
    const int tid = tid_, wid = __builtin_amdgcn_readfirstlane(tid >> 6), lane = tid & 63, wr = wid >> 2, wc = wid & 3, fr = lane & 15, fq = lane >> 4;
    const int K = g.K, nt = K / BK, lda = g.lda;
    unsigned voffA[2], voffB[2];
#pragma unroll
    for (int i = 0; i < 2; ++i) { int R, C; stage_rc(tid * 16 + i * 8192, R, C); const int Rb = Epi::PERM ? ((R & ~31) + perm32(R & 31)) : R;
        voffA[i] = (unsigned)(R * lda + C) * 2u; voffB[i] = (unsigned)(Rb * K + C) * 2u; }
    const size_t kstep = (size_t)(BK * 2);
    const size_t hstepA = (size_t)HALF * lda * 2, hstepB = (size_t)HALF * K * 2;
    const size_t tstepA = 2 * hstepA, tstepB = 2 * hstepB;
    const unsigned ldsw = (unsigned)wid * 1024u;
    const int aoff = lds_byte(wr * 64 + fr, fq * 8), boff = lds_byte(wc * 32 + fr, fq * 8);
#define PG8_SA(b, h) (((b) * 2 + (h)) * HTB)
#define PG8_SB(b, h) ((4 + (b) * 2 + (h)) * HTB)
#define PG8_STAGE(bufoff, gbase, voff) do { _Pragma("unroll") for (int _i = 0; _i < 2; ++_i) \
        __builtin_amdgcn_global_load_lds((const unsigned*)((const char*)(gbase) + (voff)[_i]), (LAS unsigned*)(lds + (bufoff) + ldsw + _i * 8192), 16, 0, 0); } while (0)
#define PG8_LDA(dst, b, h) do { _Pragma("unroll") for (int m = 0; m < 4; ++m) _Pragma("unroll") for (int k = 0; k < 2; ++k) dst[m][k] = *(const LAS bf16x8*)(lds + PG8_SA(b, h) + aoff + m * 2048 + k * 1024); } while (0)
#define PG8_LDB(dst, b, h) do { _Pragma("unroll") for (int n = 0; n < 2; ++n) _Pragma("unroll") for (int k = 0; k < 2; ++k) dst[n][k] = *(const LAS bf16x8*)(lds + PG8_SB(b, h) + boff + n * 2048 + k * 1024); } while (0)
#define PG8_MMA(ai, bj, At, Bt) do { __builtin_amdgcn_s_setprio(1); _Pragma("unroll") for (int m = 0; m < 4; ++m) _Pragma("unroll") for (int n = 0; n < 2; ++n) _Pragma("unroll") for (int k = 0; k < 2; ++k) \
        acc[ai][bj][m][n] = __builtin_amdgcn_mfma_f32_16x16x32_bf16(Bt[n][k], At[m][k], acc[ai][bj][m][n], 0, 0, 0); __builtin_amdgcn_s_setprio(0); } while (0)
#define PG8_WAIT_V(n) asm volatile("s_waitcnt vmcnt(" #n ")" ::: "memory")
#define PG8_WAIT_L(n) asm volatile("s_waitcnt lgkmcnt(" #n ")" ::: "memory")
#define PG8_BAR __builtin_amdgcn_s_barrier()
#define PG8_SCHED __builtin_amdgcn_sched_barrier(0)
    Unit cur, nxt; int ui = 0;
    if (!S.next(0, cur)) return;
    f32x4 acc[2][2][4][2];
#pragma unroll
    for (int a = 0; a < 2; ++a)
#pragma unroll
        for (int b = 0; b < 2; ++b)
#pragma unroll
            for (int m = 0; m < 4; ++m)
#pragma unroll
                for (int n = 0; n < 2; ++n) acc[a][b][m][n] = (f32x4){0.f, 0.f, 0.f, 0.f};
    bf16x8 At[4][2], B0[2][2], B1[2][2];
    const char* cA = (const char*)g.A + (size_t)cur.pm * tstepA; const char* cB = (const char*)g.Bt + (size_t)cur.pn * tstepB;
    PG8_STAGE(PG8_SB(0, 0), cB, voffB); PG8_STAGE(PG8_SB(0, 1), cB + hstepB, voffB); PG8_STAGE(PG8_SA(0, 0), cA, voffA); PG8_STAGE(PG8_SA(0, 1), cA + hstepA, voffA);
    if (wr == 1) PG8_BAR;
    PG8_WAIT_V(2); PG8_BAR;
    PG8_STAGE(PG8_SB(1, 0), cB + kstep, voffB); PG8_STAGE(PG8_SA(1, 0), cA + kstep, voffA); PG8_STAGE(PG8_SB(1, 1), cB + hstepB + kstep, voffB);
    PG8_WAIT_V(6); PG8_BAR;
    for (;;) {
        const bool has_next = S.next(ui + 1, nxt);
        const char* nA = has_next ? (const char*)g.A + (size_t)nxt.pm * tstepA : cA; const char* nB = has_next ? (const char*)g.Bt + (size_t)nxt.pn * tstepB : cB;
        for (int t = 0; t < nt; t += 2) {
            const bool last = (t == nt - 2);
            const char* a1 = cA + (size_t)(t + 1) * kstep;
            const char* a2 = last ? nA : cA + (size_t)(t + 2) * kstep; const char* b2 = last ? nB : cB + (size_t)(t + 2) * kstep;
            const char* a3 = a2 + kstep; const char* b3 = b2 + kstep;
            PG8_LDB(B0, 0, 0); PG8_LDB(B1, 0, 1); PG8_SCHED; PG8_LDA(At, 0, 0); PG8_STAGE(PG8_SA(1, 1), a1 + hstepA, voffA);
            PG8_WAIT_V(8); PG8_WAIT_L(0); PG8_BAR; PG8_MMA(0, 0, At, B0); PG8_MMA(0, 1, At, B1); PG8_BAR; PG8_SCHED;
            PG8_LDA(At, 0, 1); PG8_STAGE(PG8_SB(0, 0), b2, voffB); PG8_STAGE(PG8_SB(0, 1), b2 + hstepB, voffB); PG8_STAGE(PG8_SA(0, 0), a2, voffA);
            PG8_WAIT_V(8); PG8_WAIT_L(0); PG8_BAR; PG8_MMA(1, 0, At, B0); PG8_MMA(1, 1, At, B1); PG8_BAR; PG8_SCHED;
            PG8_LDB(B0, 1, 0); PG8_LDB(B1, 1, 1); PG8_SCHED; PG8_LDA(At, 1, 0); PG8_STAGE(PG8_SA(0, 1), a2 + hstepA, voffA);
            PG8_WAIT_V(8); PG8_WAIT_L(0); PG8_BAR; PG8_MMA(0, 0, At, B0); PG8_MMA(0, 1, At, B1); PG8_BAR; PG8_SCHED;
            PG8_LDA(At, 1, 1); PG8_STAGE(PG8_SB(1, 0), b3, voffB); PG8_STAGE(PG8_SB(1, 1), b3 + hstepB, voffB); PG8_STAGE(PG8_SA(1, 0), a3, voffA);
            PG8_WAIT_V(8); PG8_WAIT_L(0); PG8_BAR; PG8_MMA(1, 0, At, B0); PG8_MMA(1, 1, At, B1); PG8_BAR; PG8_SCHED;
        }
        if constexpr (ALIGN_EPI) { if (wr == 0) PG8_BAR; }
        E(acc, cur, wr, wc, fr, fq);
        if (!has_next) break;
#pragma unroll
        for (int a = 0; a < 2; ++a)
#pragma unroll
            for (int b = 0; b < 2; ++b)
#pragma unroll
                for (int m = 0; m < 4; ++m)
#pragma unroll
                    for (int n = 0; n < 2; ++n) acc[a][b][m][n] = (f32x4){0.f, 0.f, 0.f, 0.f};
        cur = nxt; cA = nA; cB = nB; ++ui;
        if constexpr (ALIGN_EPI) { if (wr == 1) PG8_BAR; }
    }
    PG8_WAIT_V(0);
    if constexpr (!ALIGN_EPI) { if (wr == 0) PG8_BAR; }
    PG8_BAR;
#undef PG8_SA
#undef PG8_SB
#undef PG8_STAGE
#undef PG8_LDA
#undef PG8_LDB
#undef PG8_MMA
#undef PG8_WAIT_V
#undef PG8_WAIT_L
#undef PG8_BAR
#undef PG8_SCHED
}
}

__device__ __forceinline__ int rowmap(int mode, int n0) {
    switch (mode) {
        case 1: return (n0 >> 7) * 256 + (n0 & 127);
        case 2: return (n0 >> 7) * 256 + 128 + (n0 & 127);
        case 3: return n0 < 4096 ? n0 : (n0 < 4128 ? 5120 + (n0 - 4096) : n0 - 32);
        case 4: return n0 < 1024 ? ((n0 >> 7) * 256 + (n0 & 127)) : ((((n0 - 1024) >> 7) * 256) + 128 + ((n0 - 1024) & 127));
        default: return n0;
    }
}
__device__ __forceinline__ void transpose_item(const float* W, int K, int N, bf16_t* WT, int mode, int item, int lane) {
    const int nblk = N / 32, kb = item / nblk, nb = item % nblk, k0 = 128 * kb, n0 = 32 * nb;
    const int drow = rowmap(mode, n0), lq = lane >> 3, lc = lane & 7;
    const float* src = W + (size_t)(k0 + lq * 8) * N + n0 + 4 * lc;
    f32x4 v[16];
#pragma unroll
    for (int i = 0; i < 8; ++i) { v[i] = *(const f32x4*)(src + (size_t)i * N); v[8 + i] = *(const f32x4*)(src + (size_t)(64 + i) * N); }
    bf16_t* dst = WT + (size_t)(drow + 4 * lc) * K + k0 + lq * 8;
#pragma unroll
    for (int c = 0; c < 4; ++c) {
        u32x4 o0, o1;
        o0.x = pk2(v[0][c], v[1][c]); o0.y = pk2(v[2][c], v[3][c]); o0.z = pk2(v[4][c], v[5][c]); o0.w = pk2(v[6][c], v[7][c]);
        o1.x = pk2(v[8][c], v[9][c]); o1.y = pk2(v[10][c], v[11][c]); o1.z = pk2(v[12][c], v[13][c]); o1.w = pk2(v[14][c], v[15][c]);
        *(u32x4*)(dst + (size_t)c * K) = o0; *(u32x4*)(dst + (size_t)c * K + 64) = o1;
    }
}
__device__ __forceinline__ void convert_ffn(const float* wg, const float* wu, const float* wd, bf16_t* WAgu, bf16_t* WAd, int gw, int NGW, int lane, int parts = 3) {
    constexpr int I_G = (DM / 128) * (DFF / 32), I_D = (DFF / 128) * (DM / 32);
    const int lo = (parts & 1) ? 0 : 2 * I_G, hi = (parts & 2) ? 2 * I_G + I_D : 2 * I_G;
    for (int it = lo + gw; it < hi; it += NGW) {
        int r = it;
        if (r < I_G) { transpose_item(wg, DM, DFF, WAgu, 1, r, lane); continue; } r -= I_G;
        if (r < I_G) { transpose_item(wu, DM, DFF, WAgu, 2, r, lane); continue; } r -= I_G;
        transpose_item(wd, DFF, DM, WAd, 0, r, lane);
    }
}
__device__ __forceinline__ void convert_small(const float* win, const float* wglu, const float* wout, bf16_t* Win_t, bf16_t* Wglu_t, bf16_t* Wout_t, int gw, int NGW, int lane) {
    constexpr int I_IN = (DM / 128) * (D_IN / 32), I_GLU = (DMH / 128) * (DM / 32), I_OUT = (DM / 128) * (DM / 32);
    for (int it = gw; it < I_IN + I_GLU + I_OUT; it += NGW) {
        int r = it;
        if (r < I_IN) { transpose_item(win, DM, D_IN, Win_t, 3, r, lane); continue; } r -= I_IN;
        if (r < I_GLU) { transpose_item(wglu, DMH, DM, Wglu_t, 4, r, lane); continue; } r -= I_GLU;
        transpose_item(wout, DM, DM, Wout_t, 0, r, lane);
    }
}
__device__ __forceinline__ void rms_rows_bf16(const float* srcA, const float* srcB, const float* w, bf16_t* dst, int gw, int NGW, int lane) {
    for (int m = gw; m < MROWS; m += NGW) {
        const float* src = (m < SEQ_P) ? srcA + (size_t)m * DM : srcB + (size_t)(m - SEQ_P) * DM;
        f32x4 v[8]; float s = 0.f;
#pragma unroll
        for (int j = 0; j < 8; ++j) { v[j] = ((const f32x4*)src)[lane + 64 * j]; s += (v[j].x * v[j].x + v[j].y * v[j].y) + (v[j].z * v[j].z + v[j].w * v[j].w); }
        const float rs = rsqrtf(wave_sum(s) * (1.f / DM) + EPS);
#pragma unroll
        for (int j = 0; j < 8; ++j) { const f32x4 wv = ((const f32x4*)w)[lane + 64 * j]; const f32x4 o = v[j] * rs * wv;
            u32x2 p; p.x = pk2(o.x, o.y); p.y = pk2(o.z, o.w); ((u32x2*)(dst + (size_t)m * DM))[lane + 64 * j] = p; }
    }
}
__device__ __forceinline__ void final_scale_rows(const bf16_t* xw, const float* ss, float* y, int gw, int NGW, int lane) {
    for (int m = gw; m < MROWS; m += NGW) {
        const u32x2* src = (const u32x2*)(xw + (size_t)m * DM);
        u32x2 v[8];
#pragma unroll
        for (int j = 0; j < 8; ++j) v[j] = src[lane + 64 * j];
        const float rs = rsqrtf(ss[m] * (1.f / DM) + EPS);
        f32x4* dst = (f32x4*)(y + (size_t)m * DM);
#pragma unroll
        for (int j = 0; j < 8; ++j) dst[lane + 64 * j] = (f32x4){bflo(v[j].x) * rs, bfhi(v[j].x) * rs, bflo(v[j].y) * rs, bfhi(v[j].y) * rs};
    }
}
__device__ __forceinline__ void rms_rows_f32_inplace(float* x, const float* w, int gw, int NGW, int lane) {
    for (int m = gw; m < MROWS; m += NGW) {
        float* src = x + (size_t)m * DM;
        f32x4 v[8]; float s = 0.f;
#pragma unroll
        for (int j = 0; j < 8; ++j) { v[j] = ((const f32x4*)src)[lane + 64 * j]; s += (v[j].x * v[j].x + v[j].y * v[j].y) + (v[j].z * v[j].z + v[j].w * v[j].w); }
        const float rs = rsqrtf(wave_sum(s) * (1.f / DM) + EPS);
#pragma unroll
        for (int j = 0; j < 8; ++j) { const f32x4 wv = ((const f32x4*)w)[lane + 64 * j]; ((f32x4*)src)[lane + 64 * j] = v[j] * rs * wv; }
    }
}

__device__ __forceinline__ void s5_gen(LAS unsigned char* lds, const float* a_re, const float* a_im, const float* log_dt, const float* b_re, const float* b_im,
                                       const float* c_re, const float* c_im, const float* dskip, bf16_t* W1, bf16_t* W3, int g, int part, int tid) {
    LAS float* pw = (LAS float*)lds;
    LAS float* bb = pw + 4 * 33 * 64;
    LAS float* kt = bb + 4 * 1024;
    LAS bf16_t* bt = (LAS bf16_t*)(kt + 2 * 32 * 256);
#define PW(dir, ri, d, p) pw[(((dir) * 2 + (ri)) * 33 + (d)) * 64 + (p)]
#define BB(dir, ri, p, ch) bb[(((dir) * 2 + (ri)) * 64 + (p)) * 16 + (ch)]
#define KT(dir, d, e) kt[((dir) * 32 + (d)) * 256 + (e)]
    {
        const int dir = tid >> 8, p = (tid >> 2) & 63, dq = tid & 3;
        const float are = a_re[dir * 4096 + g * 64 + p], aim = a_im[dir * 4096 + g * 64 + p], dt = __expf(log_dt[dir * 64 + g]);
        const float xr = are * dt, xi = aim * dt;
        for (int d = dq; d <= 32; d += 4) { const float mag = expf((float)d * xr); float sn, cs; sincosf((float)d * xi, &sn, &cs); PW(dir, 0, d, p) = mag * cs; PW(dir, 1, d, p) = mag * sn; }
        if (dq == 0) {
            float sn, cs, sh; sincosf(xi, &sn, &cs); sh = sinf(0.5f * xi);
            const float nr = expm1f(xr) * cs - 2.f * sh * sh, ni = expf(xr) * sn;
            const float den = 1.f / (are * are + aim * aim);
            const float cr = (nr * are + ni * aim) * den, ci = (ni * are - nr * aim) * den;
            const float* br = b_re + ((size_t)(dir * 64 + g) * 64 + p) * 16; const float* bi = b_im + ((size_t)(dir * 64 + g) * 64 + p) * 16;
            for (int ch = 0; ch < 16; ++ch) { const float x = br[ch], y = bi[ch], zr = cr * x - ci * y, zi = cr * y + ci * x;
                BB(dir, 0, p, ch) = zr; BB(dir, 1, p, ch) = zi; bt[(dir * 16 + ch) * 136 + p] = (bf16_t)f2bf(zr); bt[(dir * 16 + ch) * 136 + 64 + p] = (bf16_t)f2bf(zi); }
        }
    }
    __syncthreads();
    {
        const int wid = tid >> 6, lane = tid & 63, fr = lane & 15, fq = lane >> 4;
        const int nf = 8 * part + 8;
        for (int s = wid; s < 40; s += 8) {
            const int dir = s < nf ? 0 : 1, d = s < nf ? s : s - nf;
            const float* cr = c_re + ((size_t)(dir * 64 + g) * 16 + fr) * 64; const float* ci = c_im + ((size_t)(dir * 64 + g) * 16 + fr) * 64;
            f32x4 acc = (f32x4){0.f, 0.f, 0.f, 0.f};
#pragma unroll
            for (int kk = 0; kk < 4; ++kk) {
                const int p0 = (kk & 1) * 32 + fq * 8;
                float av[8];
#pragma unroll
                for (int i = 0; i < 8; ++i) { const float c0 = cr[p0 + i], c1 = ci[p0 + i], pr = PW(dir, 0, d, p0 + i), pi = PW(dir, 1, d, p0 + i);
                    av[i] = (kk < 2) ? (c0 * pr - c1 * pi) : -(c0 * pi + c1 * pr); }
                u32x4 aw; aw.x = pk2(av[0], av[1]); aw.y = pk2(av[2], av[3]); aw.z = pk2(av[4], av[5]); aw.w = pk2(av[6], av[7]);
                const bf16x8 b = *(const LAS bf16x8*)(bt + (dir * 16 + fr) * 136 + kk * 32 + fq * 8);
                acc = MFMA16(__builtin_bit_cast(bf16x8, aw), b, acc);
            }
#pragma unroll
            for (int jj = 0; jj < 4; ++jj) KT(dir, d, (fq * 4 + jj) * 16 + fr) = acc[jj];
        }
    }
    __syncthreads();
    for (int e = tid; e < 64 * 64; e += 512) {
        const int n = part * 64 + (e >> 6), k8 = (e & 63) * 8, dir = n >> 7, ri = (n >> 6) & 1, p = n & 63, j = k8 >> 4, ch0 = k8 & 15;
        const int d = dir ? j : (31 - j);
        const float pr = PW(dir, 0, d, p), pi = PW(dir, 1, d, p);
        float v[8];
#pragma unroll
        for (int i = 0; i < 8; ++i) { const float x = BB(dir, 0, p, ch0 + i), y = BB(dir, 1, p, ch0 + i); v[i] = ri ? (pr * y + pi * x) : (pr * x - pi * y); }
        u32x4 o; o.x = pk2(v[0], v[1]); o.y = pk2(v[2], v[3]); o.z = pk2(v[4], v[5]); o.w = pk2(v[6], v[7]);
        *(u32x4*)(W1 + (size_t)n * 512 + k8) = o;
    }
    for (int e = tid; e < 128 * 96; e += 512) {
        const int n = part * 128 + e / 96, k8 = (e % 96) * 8, j = n >> 4, ch = n & 15;
        float v[8];
        if (k8 < 512) {
            const int j2 = k8 >> 4, ch0 = k8 & 15;
#pragma unroll
            for (int i = 0; i < 8; ++i) {
                float s = 0.f;
                if (j2 <= j) s += KT(0, j - j2, ch * 16 + ch0 + i);
                if (j2 >= j) s += KT(1, j2 - j, ch * 16 + ch0 + i);
                if (j2 == j && ch0 + i == ch) s += dskip[g * 16 + ch];
                v[i] = s;
            }
        } else {
            const int kk = k8 - 512, dir = kk >> 7, ri = (kk >> 6) & 1, p0 = kk & 63;
            const int d = dir ? (32 - j) : (j + 1);
            const float* cr = c_re + ((size_t)(dir * 64 + g) * 16 + ch) * 64 + p0; const float* ci = c_im + ((size_t)(dir * 64 + g) * 16 + ch) * 64 + p0;
#pragma unroll
            for (int i = 0; i < 8; ++i) { const float pr = PW(dir, 0, d, p0 + i), pi = PW(dir, 1, d, p0 + i), c0 = cr[i], c1 = ci[i];
                v[i] = ri ? -(c0 * pi + c1 * pr) : (c0 * pr - c1 * pi); }
        }
        u32x4 o; o.x = pk2(v[0], v[1]); o.y = pk2(v[2], v[3]); o.z = pk2(v[4], v[5]); o.w = pk2(v[6], v[7]);
        *(u32x4*)(W3 + (size_t)n * 768 + k8) = o;
    }
    __syncthreads();
#undef PW
#undef BB
#undef KT
}
__device__ __forceinline__ void s5_egemm(LAS unsigned char* lds, const bf16_t* Z, const bf16_t* W1, float* E, int unit, int tid) {
    const int nh = unit & 3, mb3 = (unit >> 2) % 3, g = unit / 12;
    const int wid = tid >> 6, lane = tid & 63, fr = lane & 15, fq = lane >> 4;
    const int cbase = mb3 * 256 + wid * 32;
    f32x4 acc[2][4];
#pragma unroll
    for (int m = 0; m < 2; ++m)
#pragma unroll
        for (int n = 0; n < 4; ++n) acc[m][n] = (f32x4){0.f, 0.f, 0.f, 0.f};
    const bf16_t* Ab = Z + ((size_t)(g * S5NCB + (cbase >> 4)) * 32 + (fq >> 1)) * 256 + fr * 16 + (fq & 1) * 8;
    const bf16_t* Bsrc = W1 + (size_t)g * 256 * 512 + (size_t)(nh * 64 + (tid >> 3)) * 512 + (tid & 7) * 8;
    constexpr int ROWB = 144, BUFB = 64 * ROWB;
    LAS unsigned char* bdst = lds + (tid >> 3) * ROWB + (tid & 7) * 16;
    const LAS unsigned char* brd = lds + fr * ROWB + fq * 16;
    u32x4 rb[6]; bf16x8 af[6][4];
#define S5E_LOAD(slot, it) do { rb[slot] = *(const u32x4*)(Bsrc + (it) * 64); \
        _Pragma("unroll") for (int ks = 0; ks < 2; ++ks) _Pragma("unroll") for (int m = 0; m < 2; ++m) af[slot][ks * 2 + m] = *(const bf16x8*)(Ab + m * 8192 + (2 * (it) + ks) * 512); } while (0)
#define S5E_BAR() do { asm volatile("s_waitcnt lgkmcnt(0)" ::: "memory"); __builtin_amdgcn_s_barrier(); asm volatile("" ::: "memory"); } while (0)
    S5E_LOAD(0, 0); S5E_LOAD(1, 1); S5E_LOAD(2, 2); S5E_LOAD(3, 3); S5E_LOAD(4, 4);
    *(LAS u32x4*)bdst = rb[0];
    S5E_BAR();
#pragma unroll
    for (int it = 0; it < 8; ++it) {
        if (it + 5 < 8) S5E_LOAD((it + 5) % 6, it + 5);
        const LAS unsigned char* rbuf = brd + (it & 1) * BUFB;
#pragma unroll
        for (int ks = 0; ks < 2; ++ks)
#pragma unroll
            for (int n = 0; n < 4; ++n) { const bf16x8 bf = *(const LAS bf16x8*)(rbuf + n * 16 * ROWB + ks * 64);
#pragma unroll
                for (int m = 0; m < 2; ++m) acc[m][n] = MFMA16(bf, af[it % 6][ks * 2 + m], acc[m][n]); }
        if (it + 1 < 8) *(LAS u32x4*)(bdst + ((it + 1) & 1) * BUFB) = rb[(it + 1) % 6];
        S5E_BAR();
    }
#undef S5E_LOAD
#undef S5E_BAR
#pragma unroll
    for (int m = 0; m < 2; ++m)
#pragma unroll
        for (int n = 0; n < 4; ++n)
            *(f32x4*)(E + (size_t)(cbase + m * 16 + fr) * 16384 + g * 256 + nh * 64 + n * 16 + fq * 4) = acc[m][n];
}
__device__ __forceinline__ void s5_scan(float* E, const float* a_re, const float* a_im, const float* log_dt, int task) {
    const int p = task & 63, dir = (task >> 6) & 1, g = (task >> 7) & 63, seq = task >> 13;
    const float are = a_re[dir * 4096 + g * 64 + p], aim = a_im[dir * 4096 + g * 64 + p], dt = __expf(log_dt[dir * 64 + g]);
    const float mag = expf(32.f * are * dt); float sn, cs; sincosf(32.f * aim * dt, &sn, &cs);
    const float lr = mag * cs, li = mag * sn;
    const int clo = seq ? 256 : 0, chi = seq ? 768 : 256, nc = chi - clo;
    float xr = 0.f, xi = 0.f;
    const long cstep = dir ? -16384 : 16384;
    float* q = E + (size_t)g * 256 + dir * 128 + p + (size_t)(dir ? (chi - 1) : clo) * 16384;
    bf16_t* qb = (bf16_t*)(E + (size_t)g * 256 + (size_t)(dir ? (chi - 1) : clo) * 16384) + dir * 256 + p;
#pragma unroll 1
    for (int i0 = 0; i0 < nc; i0 += 16) {
        float er[16], ei[16];
#pragma unroll
        for (int k = 0; k < 16; ++k) { er[k] = q[k * cstep]; ei[k] = q[k * cstep + 64]; }
#pragma unroll
        for (int k = 0; k < 16; ++k) {
            qb[k * cstep * 2] = (bf16_t)f2bf(xr); qb[k * cstep * 2 + 64] = (bf16_t)f2bf(xi);
            const float nr = lr * xr - li * xi + er[k], ni = lr * xi + li * xr + ei[k];
            xr = nr; xi = ni;
        }
        q += 16 * cstep; qb += 32 * cstep;
    }
}
__device__ __forceinline__ bf16x8 s5_ya(const bf16_t* Ab, const bf16_t* Xb, int m, int kk) {
    if (kk < 16) return *(const bf16x8*)(Ab + m * 8192 + kk * 512);
    const int k0 = (kk - 16) * 32;
    return *(const bf16x8*)(Xb + (size_t)m * 16 * 32768 + (k0 >> 7) * 256 + (k0 & 127));
}
__device__ __forceinline__ void s5_ygemm(LAS unsigned char* lds, const bf16_t* Z, const bf16_t* W3, const float* E, bf16_t* YG, int unit, int tid) {
    const int nq = unit & 3, mb3 = (unit >> 2) % 3, g = unit / 12;
    const int wid = tid >> 6, lane = tid & 63, fr = lane & 15, fq = lane >> 4;
    const int cbase = mb3 * 256 + wid * 32;
    f32x4 acc[2][8];
#pragma unroll
    for (int m = 0; m < 2; ++m)
#pragma unroll
        for (int n = 0; n < 8; ++n) acc[m][n] = (f32x4){0.f, 0.f, 0.f, 0.f};
    const bf16_t* Ab = Z + ((size_t)(g * S5NCB + (cbase >> 4)) * 32 + (fq >> 1)) * 256 + fr * 16 + (fq & 1) * 8;
    const bf16_t* Xb = (const bf16_t*)(E + (size_t)(cbase + fr) * 16384 + g * 256) + fq * 8;
    const bf16_t* Bsrc = W3 + (size_t)g * 512 * 768 + (size_t)(nq * 128 + (tid >> 3)) * 768 + (tid & 7) * 8;
    constexpr int ROWB = 144, BUFB = 128 * ROWB;
    LAS unsigned char* bdst = lds + (tid >> 3) * ROWB + (tid & 7) * 16;
    const LAS unsigned char* brd = lds + fr * ROWB + fq * 16;
    u32x4 rb[6][2]; bf16x8 af[6][4];
#define S5Y_LOAD(slot, it) do { rb[slot][0] = *(const u32x4*)(Bsrc + (it) * 64); rb[slot][1] = *(const u32x4*)(Bsrc + (size_t)64 * 768 + (it) * 64); \
        _Pragma("unroll") for (int ks = 0; ks < 2; ++ks) _Pragma("unroll") for (int m = 0; m < 2; ++m) af[slot][ks * 2 + m] = s5_ya(Ab, Xb, m, 2 * (it) + ks); } while (0)
#define S5Y_PUT(slot, buf) do { *(LAS u32x4*)(bdst + (buf) * BUFB) = rb[slot][0]; *(LAS u32x4*)(bdst + (buf) * BUFB + 64 * ROWB) = rb[slot][1]; } while (0)
#define S5Y_BAR() do { asm volatile("s_waitcnt lgkmcnt(0)" ::: "memory"); __builtin_amdgcn_s_barrier(); asm volatile("" ::: "memory"); } while (0)
    S5Y_LOAD(0, 0); S5Y_LOAD(1, 1); S5Y_LOAD(2, 2); S5Y_LOAD(3, 3); S5Y_LOAD(4, 4);
    S5Y_PUT(0, 0);
    S5Y_BAR();
#pragma unroll
    for (int it = 0; it < 12; ++it) {
        if (it + 5 < 12) S5Y_LOAD((it + 5) % 6, it + 5);
        const LAS unsigned char* rbuf = brd + (it & 1) * BUFB;
#pragma unroll
        for (int ks = 0; ks < 2; ++ks)
#pragma unroll
            for (int n = 0; n < 8; ++n) { const bf16x8 bf = *(const LAS bf16x8*)(rbuf + n * 16 * ROWB + ks * 64);
#pragma unroll
                for (int m = 0; m < 2; ++m) acc[m][n] = MFMA16(bf, af[it % 6][ks * 2 + m], acc[m][n]); }
        if (it + 1 < 12) S5Y_PUT((it + 1) % 6, (it + 1) & 1);
        S5Y_BAR();
    }
#undef S5Y_LOAD
#undef S5Y_PUT
#undef S5Y_BAR
#pragma unroll
    for (int m = 0; m < 2; ++m)
#pragma unroll
        for (int n = 0; n < 8; ++n)
        {
            const int tok = (cbase + m * 16 + fr) * S5T + nq * 8 + n; const f32x4 v = acc[m][n];
            u32x2 w; w.x = pk2(gelu_tanh_f(v[0]), gelu_tanh_f(v[1])); w.y = pk2(gelu_tanh_f(v[2]), gelu_tanh_f(v[3]));
            *(u32x2*)(YG + (size_t)tok * DM + g * 16 + fq * 4) = w;
        }
}

constexpr int LROW = 136;
__device__ __forceinline__ void unpack8(const u32x4 v, float (&f)[8]) {
    f[0] = bflo(v.x); f[1] = bfhi(v.x); f[2] = bflo(v.y); f[3] = bfhi(v.y); f[4] = bflo(v.z); f[5] = bfhi(v.z); f[6] = bflo(v.w); f[7] = bfhi(v.w);
}
constexpr int TRSZ = 128 * 272 + 16 * 16;
__device__ __forceinline__ int tr_piece(int e, int p) { return e * 272 + (e >> 3) * 16 + p * 16; }
#define TR_ST(img, e, s, val) (*(LAS bf16_t*)((LAS unsigned char*)(img) + tr_piece((e), (s) >> 3) + ((s) & 7) * 2) = (bf16_t)(val))
#define TR_LD8(img, e, p) (*(const LAS bf16x8*)((const LAS unsigned char*)(img) + tr_piece((e), (p))))
struct ConvW { f32x4 w0a, w0b, w1a, w1b, w2a, w2b, ba, bb; };
__device__ __forceinline__ ConvW load_convw(const float* conv_w, const float* conv_b, int cch) {
    ConvW w; w.w0a = *(const f32x4*)(conv_w + cch); w.w0b = *(const f32x4*)(conv_w + cch + 4);
    w.w1a = *(const f32x4*)(conv_w + 2048 + cch); w.w1b = *(const f32x4*)(conv_w + 2048 + cch + 4);
    w.w2a = *(const f32x4*)(conv_w + 4096 + cch); w.w2b = *(const f32x4*)(conv_w + 4096 + cch + 4);
    w.ba = *(const f32x4*)(conv_b + cch); w.bb = *(const f32x4*)(conv_b + cch + 4); return w;
}
__device__ __forceinline__ void conv8r(const u32x4 c0, const u32x4 c1, const u32x4 c2, const ConvW& w, float scale, float (&o)[8]) {
    float x0[8], x1[8], x2[8]; unpack8(c0, x0); unpack8(c1, x1); unpack8(c2, x2);
#pragma unroll
    for (int i = 0; i < 4; ++i) {
        o[i] = silu_f(x0[i] * w.w0a[i] + x1[i] * w.w1a[i] + x2[i] * w.w2a[i] + w.ba[i]) * scale;
        o[4 + i] = silu_f(x0[4 + i] * w.w0b[i] + x1[4 + i] * w.w1b[i] + x2[4 + i] * w.w2b[i] + w.bb[i]) * scale;
    }
}
__device__ __forceinline__ void load3(const bf16_t* Z, int row, int seq_lo, int seq_hi, int zcol, u32x4& c0, u32x4& c1, u32x4& c2) {
    const bf16_t* zp = Z + (size_t)row * LDZ + zcol; const u32x4 zero = (u32x4){0u, 0u, 0u, 0u};
    c1 = *(const u32x4*)zp;
    c0 = (row - 1 >= seq_lo) ? *(const u32x4*)(zp - LDZ) : zero;
    c2 = (row + 1 < seq_hi) ? *(const u32x4*)(zp + LDZ) : zero;
}
__device__ __forceinline__ void mlstm_gates_load(const float* G, int r0, int h, int tid, float (&gv)[4]) {
    gv[0] = 0.f; gv[1] = 0.f; gv[2] = 0.f; gv[3] = 0.f;
    if (tid < 128) { const float* gp = G + (size_t)(r0 + tid) * 32; gv[0] = gp[h]; gv[1] = gp[8 + h]; gv[2] = gp[16 + h]; gv[3] = gp[24 + h]; }
}
__device__ __forceinline__ void mlstm_gates_compute(LAS float* fl, const float (&gv)[4], const float* b_i, const float* b_f, int h, int tid) {
    LAS float* igf = fl + 256, *igb = fl + 384, *cf = fl + 512, *cb = fl + 640, *tot = fl + 768, *wt = fl + 776;
    const int lane = tid & 63, w = tid >> 6;
    float sf = 0.f, sb = 0.f, lb = 0.f;
    if (tid < 128) {
        igf[tid] = gv[0] + b_i[h]; igb[tid] = gv[1] + b_i[8 + h];
        sf = logsigmoid_f(gv[2] + b_f[h]); lb = logsigmoid_f(gv[3] + b_f[8 + h]); sb = lb;
#pragma unroll
        for (int o = 1; o < 64; o <<= 1) { const float yf = __shfl_up(sf, o), yb = __shfl_up(sb, o); if (lane >= o) { sf += yf; sb += yb; } }
        if (lane == 63) { wt[w * 2] = sf; wt[w * 2 + 1] = sb; }
    }
    __syncthreads();
    if (tid < 128) { const float of = w ? wt[0] : 0.f, ob = w ? wt[1] : 0.f; cf[tid] = sf + of; cb[tid] = sb - lb + ob;
        if (tid == 0) { tot[0] = wt[0] + wt[2]; tot[1] = wt[1] + wt[3]; } }
    __syncthreads();
}
__device__ __forceinline__ void mlstm_passA(LAS unsigned char* lds, const bf16_t* Z, const float* G, const float* conv_w, const float* conv_b, const float* b_i, const float* b_f,
                                            bf16_t* ST, float* NST, float* DEC, int unit, int tid) {
    const int c = unit >> 3, h = unit & 7, r0 = c * 128;
    const int seq_lo = r0 < SEQ_P ? 0 : SEQ_P, seq_hi = r0 < SEQ_P ? SEQ_P : MROWS;
    LAS bf16_t* Kt = (LAS bf16_t*)lds; LAS bf16_t* Vt = (LAS bf16_t*)(lds + TRSZ);
    LAS float* fl = (LAS float*)(lds + 104704);
    LAS float* igf = fl + 256, *igb = fl + 384, *cf = fl + 512, *cb = fl + 640, *tot = fl + 768, *wf = fl + 896, *wb = fl + 1024;
    const int wid = tid >> 6, lane = tid & 63, fr = lane & 15, fq = lane >> 4;
    float gv[4]; mlstm_gates_load(G, r0, h, tid, gv);
    {
        const int d0 = (tid & 15) * 8, kcol = 1024 + h * 128 + d0;
        const ConvW cw = load_convw(conv_w, conv_b, kcol);
        u32x4 k0[4], k1[4], k2[4], vr[4];
#pragma unroll
        for (int it = 0; it < 4; ++it) { const int row = r0 + (tid >> 4) + 32 * it; load3(Z, row, seq_lo, seq_hi, kcol, k0[it], k1[it], k2[it]); vr[it] = *(const u32x4*)(Z + (size_t)row * LDZ + 2048 + h * 128 + d0); }
#pragma unroll
        for (int it = 0; it < 4; ++it) {
            const int s = (tid >> 4) + 32 * it;
            float kv[8]; conv8r(k0[it], k1[it], k2[it], cw, 1.f, kv);
            const u32x4 v = vr[it];
#pragma unroll
            for (int i = 0; i < 8; ++i) TR_ST(Kt, d0 + i, s, f2bf(kv[i]));
            TR_ST(Vt, d0 + 0, s, v.x & 0xffffu); TR_ST(Vt, d0 + 1, s, v.x >> 16); TR_ST(Vt, d0 + 2, s, v.y & 0xffffu); TR_ST(Vt, d0 + 3, s, v.y >> 16);
            TR_ST(Vt, d0 + 4, s, v.z & 0xffffu); TR_ST(Vt, d0 + 5, s, v.z >> 16); TR_ST(Vt, d0 + 6, s, v.w & 0xffffu); TR_ST(Vt, d0 + 7, s, v.w >> 16);
        }
    }
    mlstm_gates_compute(fl, gv, b_i, b_f, h, tid);
    if (tid < 128) { wf[tid] = __expf(tot[0] - cf[tid] + igf[tid]); wb[tid] = __expf(cb[tid] + igb[tid]);
        if (tid == 0) { DEC[(c * 2 + 0) * 8 + h] = tot[0]; DEC[(c * 2 + 1) * 8 + h] = tot[1]; } }
    __syncthreads();
    bf16x8 vraw[4];
#pragma unroll
    for (int kk = 0; kk < 4; ++kk) vraw[kk] = TR_LD8(Vt, wid * 16 + fr, kk * 4 + fq);
#pragma unroll 1
    for (int dir = 0; dir < 2; ++dir) {
        const LAS float* w = dir ? wb : wf;
        f32x4 acc[8];
#pragma unroll
        for (int n = 0; n < 8; ++n) acc[n] = (f32x4){0.f, 0.f, 0.f, 0.f};
#pragma unroll
        for (int kk = 0; kk < 4; ++kk) {
            const f32x4 w0 = *(const LAS f32x4*)(w + kk * 32 + fq * 8), w1 = *(const LAS f32x4*)(w + kk * 32 + fq * 8 + 4);
            float vf[8]; unpack8(__builtin_bit_cast(u32x4, vraw[kk]), vf);
            u32x4 aw; aw.x = pk2(vf[0] * w0[0], vf[1] * w0[1]); aw.y = pk2(vf[2] * w0[2], vf[3] * w0[3]); aw.z = pk2(vf[4] * w1[0], vf[5] * w1[1]); aw.w = pk2(vf[6] * w1[2], vf[7] * w1[3]);
            const bf16x8 a = __builtin_bit_cast(bf16x8, aw);
#pragma unroll
            for (int n = 0; n < 8; ++n) { const bf16x8 b = TR_LD8(Kt, n * 16 + fr, kk * 4 + fq); acc[n] = MFMA16(b, a, acc[n]); }
        }
        LAS unsigned char* vimg = (LAS unsigned char*)Vt;
        { LAS unsigned char* wrow = vimg + tr_piece(wid * 16 + fr, 0) + fq * 8;
#pragma unroll
          for (int n = 0; n < 8; ++n) { u32x2 ww; ww.x = pk2(acc[n][0], acc[n][1]); ww.y = pk2(acc[n][2], acc[n][3]); *(LAS u32x2*)(wrow + n * 32) = ww; } }
        asm volatile("s_waitcnt lgkmcnt(0)" ::: "memory");
        u32x4* out = (u32x4*)(ST + (size_t)((c * 2 + dir) * 8 + h) * 16384 + wid * 16 * 128);
#pragma unroll
        for (int i = 0; i < 4; ++i) { const int q = lane + 64 * i; out[q] = *(const LAS u32x4*)(vimg + tr_piece(wid * 16 + (q >> 4), q & 15)); }
        asm volatile("s_waitcnt lgkmcnt(0)" ::: "memory");
    }
    {
        const int dir = tid >> 8, dk = (tid >> 1) & 127, hf = tid & 1; const LAS float* w = dir ? wb : wf; float sacc = 0.f;
#pragma unroll
        for (int j8 = 0; j8 < 8; ++j8) { const int j0 = hf * 64 + j8 * 8; float kf[8]; unpack8(__builtin_bit_cast(u32x4, TR_LD8(Kt, dk, j0 >> 3)), kf);
#pragma unroll
            for (int i = 0; i < 8; ++i) sacc += w[j0 + i] * kf[i]; }
        sacc += __shfl_xor(sacc, 1);
        if (hf == 0) NST[(size_t)((c * 2 + dir) * 8 + h) * 128 + dk] = sacc;
    }
    __syncthreads();
}
__device__ __forceinline__ void mlstm_scan(bf16_t* ST, float* NST, const float* DEC, int task) {
    if (task < 131072) {
        const int piece = task & 4095, chain = task >> 12, h = chain & 7, dir = (chain >> 3) & 1, seq = chain >> 4;
        const int clo = seq ? 64 : 0, chi = seq ? 192 : 64, nc = chi - clo;
        float run[4] = {0.f, 0.f, 0.f, 0.f};
#pragma unroll 8
        for (int i = 0; i < nc; ++i) {
            const int c = dir ? (chi - 1 - i) : (clo + i);
            u32x2* q = (u32x2*)(ST + (size_t)((c * 2 + dir) * 8 + h) * 16384 + piece * 4);
            const u32x2 lv = *q;
            const float dec = __expf(DEC[(c * 2 + dir) * 8 + h]);
            u32x2 o; o.x = pk2(run[0], run[1]); o.y = pk2(run[2], run[3]);
            *q = o;
            run[0] = dec * run[0] + bflo(lv.x); run[1] = dec * run[1] + bfhi(lv.x); run[2] = dec * run[2] + bflo(lv.y); run[3] = dec * run[3] + bfhi(lv.y);
        }
    } else if (task < 131072 + 4096) {
        const int t2 = task - 131072, dk = t2 & 127, chain = t2 >> 7, h = chain & 7, dir = (chain >> 3) & 1, seq = chain >> 4;
        const int clo = seq ? 64 : 0, chi = seq ? 192 : 64, nc = chi - clo;
        float run = 0.f;
#pragma unroll 8
        for (int i = 0; i < nc; ++i) {
            const int c = dir ? (chi - 1 - i) : (clo + i);
            float* q = NST + (size_t)((c * 2 + dir) * 8 + h) * 128 + dk;
            const float l = *q; const float dec = __expf(DEC[(c * 2 + dir) * 8 + h]);
            *q = run; run = dec * run + l;
        }
    }
}
template <int DIR>
__device__ __forceinline__ void mlstm_dir(const f32x4 (&S)[8], f32x4 (&acc)[8], f32x4 (&hs)[8], LAS bf16_t* Ps, const LAS bf16_t* Vt, const LAS float* fl, int wid, int fr, int fq) {
    const LAS float* ig = fl + (DIR ? 384 : 256); const LAS float* cc = fl + (DIR ? 640 : 512); const LAS float* tot = fl + 768; const LAS float* nq = fl + 1152;
    const int t = wid * 16 + fr;
    const float ct = cc[t], si = DIR ? __expf(tot[1] - ct) : __expf(ct);
    float rsum = 0.f;
#pragma unroll
    for (int n = 0; n < 8; ++n) {
        const int s4 = n * 16 + fq * 4;
        const f32x4 cs = *(const LAS f32x4*)(cc + s4), is = *(const LAS f32x4*)(ig + s4);
        float v[4];
#pragma unroll
        for (int jj = 0; jj < 4; ++jj) {
            const int s = s4 + jj;
            const bool ok = DIR ? (s >= t) : (s <= t);
            const float arg = DIR ? (cs[jj] - ct + is[jj]) : (ct - cs[jj] + is[jj]);
            v[jj] = ok ? S[n][jj] * __expf(arg) : 0.f;
            rsum += v[jj];
        }
        u32x2 w; w.x = pk2(v[0], v[1]); w.y = pk2(v[2], v[3]);
        *(LAS u32x2*)(Ps + t * LROW + s4) = w;
    }
    rsum += __shfl_xor(rsum, 16); rsum += __shfl_xor(rsum, 32);
    const float den = rsum + si * nq[DIR * 128 + t], scl = 1.f / fmaxf(fabsf(den), 1.f);
#pragma unroll
    for (int n = 0; n < 8; ++n) acc[n] *= si;
    asm volatile("s_waitcnt lgkmcnt(0)" ::: "memory");
#pragma unroll
    for (int kk = 0; kk < 4; ++kk) {
        const bf16x8 p = *(const LAS bf16x8*)(Ps + (wid * 16 + fr) * LROW + kk * 32 + fq * 8);
#pragma unroll
        for (int n = 0; n < 8; ++n) { const bf16x8 vf = TR_LD8(Vt, n * 16 + fr, kk * 4 + fq); acc[n] = MFMA16(vf, p, acc[n]); }
    }
#pragma unroll
    for (int n = 0; n < 8; ++n) hs[n] += acc[n] * scl;
    asm volatile("s_waitcnt lgkmcnt(0)" ::: "memory");
}
__device__ __forceinline__ void mlstm_passC(LAS unsigned char* lds, const bf16_t* Z, const float* G, const float* conv_w, const float* conv_b, const float* b_i, const float* b_f,
                                            const float* norm_w, const bf16_t* ST, const float* NST, bf16_t* MIX, int unit, int tid) {
    const int c = unit >> 3, h = unit & 7, r0 = c * 128;
    const int seq_lo = r0 < SEQ_P ? 0 : SEQ_P, seq_hi = r0 < SEQ_P ? SEQ_P : MROWS;
    LAS bf16_t* Qs = (LAS bf16_t*)lds; LAS bf16_t* Ks = Qs + 128 * LROW; LAS bf16_t* Vt = Ks + 128 * LROW; LAS bf16_t* Ps = Ks;
    LAS float* fl = (LAS float*)(lds + 104704);
    LAS float* nst = fl + 896  , *nq = fl + 1152  ;
    const int wid = tid >> 6, lane = tid & 63, fr = lane & 15, fq = lane >> 4;
    float gv[4]; mlstm_gates_load(G, r0, h, tid, gv);
    float nstv = 0.f; if (tid < 256) nstv = NST[(size_t)((c * 2 + (tid >> 7)) * 8 + h) * 128 + (tid & 127)];
    {
        const int d0 = (tid & 15) * 8, qcol = h * 128 + d0, kcol = 1024 + h * 128 + d0;
#pragma unroll 1
        for (int hb = 0; hb < 2; ++hb) {
        u32x4 q0[2], q1[2], q2[2], k0[2], k1[2], k2[2], vr[2];
#pragma unroll
        for (int it = 0; it < 2; ++it) { const int row = r0 + (tid >> 4) + 32 * (2 * hb + it);
            load3(Z, row, seq_lo, seq_hi, qcol, q0[it], q1[it], q2[it]); load3(Z, row, seq_lo, seq_hi, kcol, k0[it], k1[it], k2[it]);
            vr[it] = *(const u32x4*)(Z + (size_t)row * LDZ + 2048 + h * 128 + d0); }
        {   const ConvW cwq = load_convw(conv_w, conv_b, qcol);
#pragma unroll
            for (int it = 0; it < 2; ++it) { const int s = (tid >> 4) + 32 * (2 * hb + it);
                float qv[8]; conv8r(q0[it], q1[it], q2[it], cwq, 0.08838834764831845f, qv);
                u32x4 o; o.x = pk2(qv[0], qv[1]); o.y = pk2(qv[2], qv[3]); o.z = pk2(qv[4], qv[5]); o.w = pk2(qv[6], qv[7]);
                *(LAS u32x4*)(Qs + s * LROW + d0) = o; } }
        asm volatile("" ::: "memory");
        {   const ConvW cwk = load_convw(conv_w, conv_b, kcol);
#pragma unroll
            for (int it = 0; it < 2; ++it) { const int s = (tid >> 4) + 32 * (2 * hb + it);
                float kv[8]; conv8r(k0[it], k1[it], k2[it], cwk, 1.f, kv);
                u32x4 o; o.x = pk2(kv[0], kv[1]); o.y = pk2(kv[2], kv[3]); o.z = pk2(kv[4], kv[5]); o.w = pk2(kv[6], kv[7]);
                *(LAS u32x4*)(Ks + s * LROW + d0) = o; } }
#pragma unroll
        for (int it = 0; it < 2; ++it) { const int s = (tid >> 4) + 32 * (2 * hb + it); const u32x4 v = vr[it];
            TR_ST(Vt, d0 + 0, s, v.x & 0xffffu); TR_ST(Vt, d0 + 1, s, v.x >> 16); TR_ST(Vt, d0 + 2, s, v.y & 0xffffu); TR_ST(Vt, d0 + 3, s, v.y >> 16);
            TR_ST(Vt, d0 + 4, s, v.z & 0xffffu); TR_ST(Vt, d0 + 5, s, v.z >> 16); TR_ST(Vt, d0 + 6, s, v.w & 0xffffu); TR_ST(Vt, d0 + 7, s, v.w >> 16); }
        }
    }
    u32x4 cfr[4];
    { const u32x4* sf = (const u32x4*)(ST + (size_t)((c * 2 + 0) * 8 + h) * 16384) + tid;
#pragma unroll
      for (int i = 0; i < 4; ++i) cfr[i] = sf[512 * i]; }
    if (tid < 256) nst[tid] = nstv;
    mlstm_gates_compute(fl, gv, b_i, b_f, h, tid);
    LAS unsigned char* CF = lds + 110336;
#pragma unroll
    for (int i = 0; i < 4; ++i) { const int q = tid + 512 * i, e = q >> 4, pp = q & 15; *(LAS u32x4*)(CF + e * 256 + ((pp ^ (e & 15)) << 4)) = cfr[i]; }
    u32x4 cbr[4];
    { const u32x4* sb = (const u32x4*)(ST + (size_t)((c * 2 + 1) * 8 + h) * 16384) + tid;
#pragma unroll
      for (int i = 0; i < 4; ++i) cbr[i] = sb[512 * i]; }
    {
        const int t = tid >> 2, part = tid & 3; float sf = 0.f, sb = 0.f;
#pragma unroll
        for (int j8 = 0; j8 < 4; ++j8) { const int j0 = part * 32 + j8 * 8; float qf[8]; unpack8(*(const LAS u32x4*)(Qs + t * LROW + j0), qf);
#pragma unroll
            for (int i = 0; i < 8; ++i) { sf += qf[i] * nst[j0 + i]; sb += qf[i] * nst[128 + j0 + i]; } }
        sf += __shfl_xor(sf, 1); sf += __shfl_xor(sf, 2); sb += __shfl_xor(sb, 1); sb += __shfl_xor(sb, 2);
        if (part == 0) { nq[t] = sf; nq[128 + t] = sb; }
    }
    bf16x8 qa[4];
#pragma unroll
    for (int kk = 0; kk < 4; ++kk) qa[kk] = *(const LAS bf16x8*)(Qs + (wid * 16 + fr) * LROW + kk * 32 + fq * 8);
    f32x4 S[8];
#pragma unroll
    for (int n = 0; n < 8; ++n) S[n] = (f32x4){0.f, 0.f, 0.f, 0.f};
#pragma unroll
    for (int kk = 0; kk < 4; ++kk)
#pragma unroll
        for (int n = 0; n < 8; ++n) { const bf16x8 b = *(const LAS bf16x8*)(Ks + (n * 16 + fr) * LROW + kk * 32 + fq * 8); S[n] = MFMA16(b, qa[kk], S[n]); }
    __syncthreads();
    f32x4 hs[8];
#pragma unroll
    for (int n = 0; n < 8; ++n) hs[n] = (f32x4){0.f, 0.f, 0.f, 0.f};
    f32x4 Xf[8];
#pragma unroll
    for (int n = 0; n < 8; ++n) Xf[n] = (f32x4){0.f, 0.f, 0.f, 0.f};
#pragma unroll
    for (int kk = 0; kk < 4; ++kk)
#pragma unroll
        for (int n = 0; n < 8; ++n) { const bf16x8 b0 = *(const LAS bf16x8*)(CF + (n * 16 + fr) * 256 + (((kk * 4 + fq) ^ fr) << 4)); Xf[n] = MFMA16(b0, qa[kk], Xf[n]); }
    LAS unsigned char* CB = (LAS unsigned char*)Qs;
#pragma unroll
    for (int i = 0; i < 4; ++i) { const int q = tid + 512 * i, e = q >> 4, p = q & 15; *(LAS u32x4*)(CB + e * 256 + ((p ^ (e & 15)) << 4)) = cbr[i]; }
    u32x4 ogr[4];
#pragma unroll
    for (int i = 0; i < 4; ++i) { const int q = lane + 64 * i; ogr[i] = *(const u32x4*)(Z + (size_t)(r0 + wid * 16 + (q >> 4)) * LDZ + 3072 + h * 128 + (q & 15) * 8); }
    mlstm_dir<0>(S, Xf, hs, Ps, Vt, fl, wid, fr, fq);
    __syncthreads();
    f32x4 Xb[8];
#pragma unroll
    for (int n = 0; n < 8; ++n) Xb[n] = (f32x4){0.f, 0.f, 0.f, 0.f};
#pragma unroll
    for (int kk = 0; kk < 4; ++kk)
#pragma unroll
        for (int n = 0; n < 8; ++n) { const bf16x8 b1 = *(const LAS bf16x8*)(CB + (n * 16 + fr) * 256 + (((kk * 4 + fq) ^ fr) << 4)); Xb[n] = MFMA16(b1, qa[kk], Xb[n]); }
    mlstm_dir<1>(S, Xb, hs, Ps, Vt, fl, wid, fr, fq);
    {
        float s = 0.f;
#pragma unroll
        for (int n = 0; n < 8; ++n) s += (hs[n][0] + hs[n][1]) + (hs[n][2] + hs[n][3]);
        s += __shfl_xor(s, 16); s += __shfl_xor(s, 32);
        const float mu = s * (1.f / 128.f); float q = 0.f;
#pragma unroll
        for (int n = 0; n < 8; ++n) { const f32x4 d = hs[n] - mu; q += (d[0] * d[0] + d[1] * d[1]) + (d[2] * d[2] + d[3] * d[3]); }
        q += __shfl_xor(q, 16); q += __shfl_xor(q, 32);
        const float rstd = rsqrtf(q * (1.f / 128.f) + EPS);
        LAS unsigned char* wt = (LAS unsigned char*)Ps + (wid * 16) * (LROW * 2);
#pragma unroll
        for (int i = 0; i < 4; ++i) { const int q = lane + 64 * i; *(LAS u32x4*)(wt + (q >> 4) * (LROW * 2) + (q & 15) * 16) = ogr[i]; }
        asm volatile("s_waitcnt lgkmcnt(0)" ::: "memory");
        const float* nw = norm_w + h * 128 + fq * 4;
        LAS unsigned char* urow = wt + fr * (LROW * 2) + fq * 8;
#pragma unroll
        for (int n = 0; n < 8; ++n) {
            LAS u32x2* up = (LAS u32x2*)(urow + n * 32);
            const u32x2 og = *up; const f32x4 wv = *(const f32x4*)(nw + n * 16);
            const float o0 = (hs[n][0] - mu) * rstd * wv[0] * sigmoid_f(bflo(og.x)), o1 = (hs[n][1] - mu) * rstd * wv[1] * sigmoid_f(bfhi(og.x));
            const float o2 = (hs[n][2] - mu) * rstd * wv[2] * sigmoid_f(bflo(og.y)), o3 = (hs[n][3] - mu) * rstd * wv[3] * sigmoid_f(bfhi(og.y));
            u32x2 w; w.x = pk2(o0, o1); w.y = pk2(o2, o3); *up = w;
        }
        asm volatile("s_waitcnt lgkmcnt(0)" ::: "memory");
#pragma unroll
        for (int i = 0; i < 4; ++i) { const int q = lane + 64 * i, r = q >> 4, p = q & 15;
            *(u32x4*)(MIX + (size_t)(r0 + wid * 16 + r) * DM + h * 128 + p * 8) = *(const LAS u32x4*)(wt + r * (LROW * 2) + p * 16); }
    }
    __syncthreads();
}

#define XB_TMO      128
#define XB_XCNT(j)  (256  + 64 * (j))
#define XB_XSUB(j)  (1280 + 64 * (j))
#define XB_XGEN(j)  (2304 + 64 * (j))
#define XB_TOP      3328
#define XB_TOPGEN   3392
#define XCD_BAR_WORDS 3456
#define XB_SPIN_CAP (1u << 18)
__device__ __forceinline__ unsigned xb_ld(unsigned* p)              { return __hip_atomic_load(p, __ATOMIC_RELAXED, __HIP_MEMORY_SCOPE_AGENT); }
__device__ __forceinline__ unsigned xb_add(unsigned* p, unsigned v) { return __hip_atomic_fetch_add(p, v, __ATOMIC_RELAXED, __HIP_MEMORY_SCOPE_AGENT); }
__device__ __forceinline__ unsigned xb_xcc_id() { return (unsigned)__builtin_amdgcn_s_getreg((3 << 11) | 20) & 0xFu; }
#define XB_SPIN(cond, bar) do { unsigned _sp = 0; while (cond) { __builtin_amdgcn_s_sleep(1); \
    if ((++_sp & 255u) == 0u) { if (xb_ld(&(bar)[XB_TMO])) break; if (_sp > XB_SPIN_CAP) { atomicAdd(&(bar)[XB_TMO], 1u); break; } } } } while (0)
struct XcdBarrier { unsigned* bar; unsigned x; volatile LAS unsigned* st; };
__device__ __forceinline__ XcdBarrier xcd_barrier_post(unsigned* bar, volatile LAS unsigned* st) {
    XcdBarrier b; b.bar = bar; b.x = xb_xcc_id(); b.st = st;
    if (threadIdx.x == 0) (void)xb_add(&bar[XB_XCNT(b.x)], 1u);
    return b;
}
__device__ __forceinline__ void xcd_barrier_complete(unsigned* bar, unsigned x, unsigned& nloc, unsigned& nx) {
    const unsigned G = gridDim.x * gridDim.y * gridDim.z;
    unsigned sum, cnt, mine, sp = 0u;
    for (;;) {
        sum = 0u; cnt = 0u; mine = 0u;
#pragma unroll
        for (unsigned j = 0; j < 16; ++j) { const unsigned c = xb_ld(&bar[XB_XCNT(j)]); sum += c; cnt += (c > 0u) ? 1u : 0u; mine = (j == x) ? c : mine; }
        if (sum == G) break;
        __builtin_amdgcn_s_sleep(1);
        if ((++sp & 255u) == 0u) { if (xb_ld(&bar[XB_TMO])) break; if (sp > XB_SPIN_CAP) { atomicAdd(&bar[XB_TMO], 1u); break; } }
    }
    nloc = mine > 0u ? mine : 1u; nx = cnt > 0u ? cnt : 1u;
}
__device__ __forceinline__ void xcd_barrier(const XcdBarrier& b) {
    asm volatile("s_waitcnt vmcnt(0)" ::: "memory");
    __syncthreads();
    if (threadIdx.x == 0) {
        unsigned* bar = b.bar;
        __builtin_amdgcn_s_waitcnt(0);
        unsigned nloc = b.st[0], nx = b.st[1];
        if (nloc == 0u) { xcd_barrier_complete(bar, b.x, nloc, nx); b.st[0] = nloc; b.st[1] = nx; }
        const unsigned old = xb_add(&bar[XB_XSUB(b.x)], 1u);
        const unsigned gen = old / nloc;
        if (old + 1u == (gen + 1u) * nloc) {
            __builtin_amdgcn_fence(__ATOMIC_RELEASE, "agent");
            asm volatile("s_waitcnt vmcnt(0)" ::: "memory");
            const unsigned og = xb_add(&bar[XB_TOP], 1u);
            const unsigned tg = og / nx;
            if (og + 1u == (tg + 1u) * nx) xb_add(&bar[XB_TOPGEN], 1u);
            else XB_SPIN(xb_ld(&bar[XB_TOPGEN]) == tg, bar);
            __builtin_amdgcn_fence(__ATOMIC_ACQUIRE, "agent");
            xb_add(&bar[XB_XGEN(b.x)], 1u);
            asm volatile("s_waitcnt vmcnt(0)" ::: "memory");
        } else {
            XB_SPIN(xb_ld(&bar[XB_XGEN(b.x)]) == gen, bar);
            __builtin_amdgcn_fence(__ATOMIC_ACQUIRE, "agent");
            asm volatile("s_waitcnt vmcnt(0)" ::: "memory");
        }
    }
    __syncthreads();
}

#define PACK12(a,b,c,d,e,f,g,h,i,j,k,l) ((unsigned long long)(a) | ((unsigned long long)(b) << 5) | ((unsigned long long)(c) << 10) | ((unsigned long long)(d) << 15) | ((unsigned long long)(e) << 20) | ((unsigned long long)(f) << 25) | ((unsigned long long)(g) << 30) | ((unsigned long long)(h) << 35) | ((unsigned long long)(i) << 40) | ((unsigned long long)(j) << 45) | ((unsigned long long)(k) << 50) | ((unsigned long long)(l) << 55))
struct Args { const float* in[28]; float* out; unsigned char* ws; int ph_lo, ph_hi; };
constexpr int N_PHASES = 17;

#define PTR(k) ((unsigned char*)(((unsigned long long)(unsigned)__builtin_amdgcn_readfirstlane((int)ptab[2 * (k) + 1]) << 32) | (unsigned long long)(unsigned)__builtin_amdgcn_readfirstlane((int)ptab[2 * (k)])))
#define INP(k) ((const float*)PTR(k))
#define OUTP ((float*)PTR(28))
#define WSP(off) (PTR(29) + (off))
template <int K>
__device__ __forceinline__ void run_phase(LAS unsigned char* lds, volatile LAS unsigned* ptab) {
    int tid_ = threadIdx.x; asm volatile("" : "+v"(tid_));
    const int tid = tid_, lane = tid & 63, wave = __builtin_amdgcn_readfirstlane(tid >> 6);
    const int G = gridDim.x, bx = blockIdx.x;
    const int gw = bx * 8 + wave, NGW = G * 8;
    if constexpr (K == 0) {
        convert_ffn(INP(3), INP(4), INP(5), (bf16_t*)WSP(WS_WAGU), (bf16_t*)WSP(WS_WAD), gw, NGW, lane);
        {
            const int nwg1 = (MROWS / 256) * (2 * DFF / 256), nidle = ((nwg1 + G - 1) / G) * G - nwg1;
            if (nidle == 0) convert_small(INP(7), INP(21), INP(22), (bf16_t*)WSP(WS_WIN), (bf16_t*)WSP(WS_WGLU), (bf16_t*)WSP(WS_WOUT), gw, NGW, lane);
        }
        bf16_t* Win_t = (bf16_t*)WSP(WS_WIN);
        for (int i = bx * 512 + tid; i < (NZ - D_IN) * DM / 8; i += G * 512) ((u32x4*)(Win_t + (size_t)D_IN * DM))[i] = (u32x4){0u, 0u, 0u, 0u};
        rms_rows_bf16(INP(0), INP(1), INP(2), (bf16_t*)WSP(WS_XN), gw, NGW, lane);
    }
    if constexpr (K == 1) {
        pg8::Gemm g{(const bf16_t*)WSP(WS_XN), (const bf16_t*)WSP(WS_WAGU), MROWS, 2 * DFF, DM, DM}; pg8::StaticOrder S; S.init(MROWS, 2 * DFF, G, bx);
        pg8::EpiSwiglu E{(bf16_t*)WSP(WS_BIG), DFF, 0, nullptr};
        pg8::gemm_phase<pg8::EpiSwiglu, true>(lds, g, S, E);
        {
            const int nwg1 = (MROWS / 256) * (2 * DFF / 256), nidle = ((nwg1 + G - 1) / G) * G - nwg1, first_idle = G - nidle;
            if (nidle > 0 && bx >= first_idle)
                convert_small(INP(7), INP(21), INP(22), (bf16_t*)WSP(WS_WIN), (bf16_t*)WSP(WS_WGLU), (bf16_t*)WSP(WS_WOUT), (bx - first_idle) * 8 + wave, nidle * 8, lane);
        }
    }
    if constexpr (K == 2) {
        for (int u = bx; u < 256; u += G)
            s5_gen(lds, INP(13), INP(14), INP(15), INP(16), INP(17), INP(18), INP(19), INP(20),
                   (bf16_t*)WSP(WS_S5W1) + (size_t)(u >> 2) * 256 * 512, (bf16_t*)WSP(WS_S5W3) + (size_t)(u >> 2) * 512 * 768, u >> 2, u & 3, tid);
        pg8::Gemm g{(const bf16_t*)WSP(WS_BIG), (const bf16_t*)WSP(WS_WAD), MROWS, DM, DFF, DFF}; pg8::StaticOrder S; S.init(MROWS, DM, G, bx);
        pg8::EpiResid E{INP(0), INP(1), OUTP, DM, 0.5f, (bf16_t*)WSP(WS_XN), INP(6), (float*)WSP(WS_SS1)};
        pg8::gemm_phase<pg8::EpiResid, true>(lds, g, S, E);
    }
    if constexpr (K == 4) {
        pg8::Gemm g{(const bf16_t*)WSP(WS_XN), (const bf16_t*)WSP(WS_WIN), MROWS, NZ, DM, DM}; pg8::StaticOrder S; S.init(MROWS, NZ, G, bx);
        pg8::EpiZ E{(bf16_t*)WSP(WS_BIG), LDZ, (float*)WSP(WS_GATES), 20, (const float*)WSP(WS_SS1), (bf16_t*)WSP(WS_UG)};
        pg8::gemm_phase<pg8::EpiZ, true>(lds, g, S, E);
    }
    if constexpr (K == 5) { const bf16_t* Z = (const bf16_t*)WSP(WS_UG); const bf16_t* W1 = (const bf16_t*)WSP(WS_S5W1); float* E = (float*)WSP(WS_S5E);
        for (int u = bx; u < 64 * 3 * 4; u += G) s5_egemm(lds, Z, W1, E, u, tid); }
    if constexpr (K == 6) { float* E = (float*)WSP(WS_S5E); const float* are = INP(13); const float* aim = INP(14); const float* ldt = INP(15);
        for (int t = bx * 512 + tid; t < 16384; t += G * 512) s5_scan(E, are, aim, ldt, t); }
    if constexpr (K == 7) { const bf16_t* Z = (const bf16_t*)WSP(WS_UG); const bf16_t* W3 = (const bf16_t*)WSP(WS_S5W3); const float* E = (const float*)WSP(WS_S5E); bf16_t* YG = (bf16_t*)WSP(WS_XN);
        for (int u = bx; u < 64 * 3 * 4; u += G) s5_ygemm(lds, Z, W3, E, YG, u, tid); }
    if constexpr (K == 8) {
        bf16_t* XN = (bf16_t*)WSP(WS_XN);
        pg8::Gemm g{XN, (const bf16_t*)WSP(WS_WGLU), MROWS, DM, DMH, DM}; pg8::StaticOrder S; S.init(MROWS, DM, G, bx);
        pg8::EpiSwiglu E{XN + DMH, DM, 1, nullptr};
        pg8::gemm_phase<pg8::EpiSwiglu, true>(lds, g, S, E);
    }
    if constexpr (K == 9) { const bf16_t* Z = (const bf16_t*)WSP(WS_BIG); const float* GA = (const float*)WSP(WS_GATES); bf16_t* ST = (bf16_t*)WSP(WS_ST); float* NST = (float*)WSP(WS_NST); float* DEC = (float*)WSP(WS_DEC);
        const float* cw = INP(8); const float* cb = INP(9); const float* bi = INP(10); const float* bf = INP(11);
        for (int u = bx; u < NCH * 8; u += G) mlstm_passA(lds, Z, GA, cw, cb, bi, bf, ST, NST, DEC, u, tid); }
    if constexpr (K == 10) { bf16_t* ST = (bf16_t*)WSP(WS_ST); float* NST = (float*)WSP(WS_NST); const float* DEC = (const float*)WSP(WS_DEC);
        for (int t = bx * 512 + tid; t < 131072 + 4096; t += G * 512) mlstm_scan(ST, NST, DEC, t); }
    if constexpr (K == 11) { const bf16_t* Z = (const bf16_t*)WSP(WS_BIG); const float* GA = (const float*)WSP(WS_GATES); const bf16_t* ST = (const bf16_t*)WSP(WS_ST); const float* NST = (const float*)WSP(WS_NST);
        const float* cw = INP(8); const float* cb = INP(9); const float* bi = INP(10); const float* bf = INP(11); const float* nw = INP(12); bf16_t* MIX = (bf16_t*)WSP(WS_XN);
        for (int u = bx; u < NCH * 8; u += G) mlstm_passC(lds, Z, GA, cw, cb, bi, bf, nw, ST, NST, MIX, u, tid); }
    if constexpr (K == 12) {
        float* out = OUTP;
        pg8::Gemm g{(const bf16_t*)WSP(WS_XN), (const bf16_t*)WSP(WS_WOUT), MROWS, DM, DM, DM}; pg8::StaticOrder S; S.init(MROWS, DM, G, bx);
        pg8::EpiResid E{out, out + (size_t)SEQ_P * DM, out, DM, 1.0f, (bf16_t*)WSP(WS_XN2), INP(23), (float*)WSP(WS_SS2)};
        pg8::gemm_phase<pg8::EpiResid, true>(lds, g, S, E);
    }
    if constexpr (K == 13) {
        const int nwg1 = (MROWS / 256) * (2 * DFF / 256), nidle = ((nwg1 + G - 1) / G) * G - nwg1;
        convert_ffn(INP(24), INP(25), INP(26), (bf16_t*)WSP(WS_WAGU2), (bf16_t*)WSP(WS_WAD2), gw, NGW, lane, nidle >= 64 ? 1 : 3);
    }
    if constexpr (K == 14) {
        pg8::Gemm g{(const bf16_t*)WSP(WS_XN2), (const bf16_t*)WSP(WS_WAGU2), MROWS, 2 * DFF, DM, DM}; pg8::StaticOrder S; S.init(MROWS, 2 * DFF, G, bx);
        pg8::EpiSwiglu E{(bf16_t*)WSP(WS_H2), DFF, 0, (const float*)WSP(WS_SS2)};
        pg8::gemm_phase<pg8::EpiSwiglu, true>(lds, g, S, E);
        {
            const int nwg1 = (MROWS / 256) * (2 * DFF / 256), nidle = ((nwg1 + G - 1) / G) * G - nwg1, first_idle = G - nidle;
            if (nidle >= 64 && bx >= first_idle)
                convert_ffn(INP(24), INP(25), INP(26), (bf16_t*)WSP(WS_WAGU2), (bf16_t*)WSP(WS_WAD2), (bx - first_idle) * 8 + wave, nidle * 8, lane, 2);
        }
    }
    if constexpr (K == 15) {
        float* out = OUTP;
        pg8::Gemm g{(const bf16_t*)WSP(WS_H2), (const bf16_t*)WSP(WS_WAD2), MROWS, DM, DFF, DFF}; pg8::StaticOrder S; S.init(MROWS, DM, G, bx);
        pg8::EpiResid E{out, out + (size_t)SEQ_P * DM, nullptr, DM, 0.5f, (bf16_t*)WSP(WS_XN2), INP(27), (float*)WSP(WS_SS3)};
        pg8::gemm_phase<pg8::EpiResid, true>(lds, g, S, E);
    }
    if constexpr (K == 16) final_scale_rows((const bf16_t*)WSP(WS_XN2), (const float*)WSP(WS_SS3), OUTP, gw, NGW, lane);
}

#ifndef PROBE
#define PROBE 0
#endif
__global__ void __launch_bounds__(512, 2) mega_fwd(Args args) {
    extern __shared__ __attribute__((aligned(16))) unsigned char lds_raw[];
    LAS unsigned char* lds = (LAS unsigned char*)lds_raw;
    cg::grid_group grid = cg::this_grid();
    volatile LAS unsigned* ptab = (volatile LAS unsigned*)(lds + 143360);
    if (threadIdx.x == 0) {
#pragma unroll
        for (int i = 0; i < 28; ++i) { const unsigned long long v = (unsigned long long)args.in[i]; ptab[2 * i] = (unsigned)v; ptab[2 * i + 1] = (unsigned)(v >> 32); }
        { const unsigned long long v = (unsigned long long)args.out; ptab[56] = (unsigned)v; ptab[57] = (unsigned)(v >> 32); }
        { const unsigned long long v = (unsigned long long)args.ws; ptab[58] = (unsigned)v; ptab[59] = (unsigned)(v >> 32); }
    }
    volatile LAS unsigned* bst = (volatile LAS unsigned*)(lds + 143360 + 256);
    if (threadIdx.x < 2) bst[threadIdx.x] = 0u;
    __syncthreads();
    XcdBarrier bar = xcd_barrier_post((unsigned*)args.ws + 4096, bst);
#define RUN(k) run_phase<k>(lds, ptab)
#define SYNC xcd_barrier(bar)
    RUN(0);
    if (args.ph_lo != 0) grid.sync();
    SYNC;
#if PROBE == 5
    RUN(0); SYNC;
#endif
    RUN(1); SYNC; RUN(2); SYNC; RUN(4); SYNC;
    RUN(5); SYNC; RUN(6); SYNC;
#if PROBE == 7
    RUN(5); SYNC; RUN(6); SYNC;
#endif
    RUN(7); SYNC;
#if PROBE == 1
    RUN(5); SYNC; RUN(6); SYNC; RUN(7); SYNC;
#endif
    RUN(8);
    RUN(9); SYNC; RUN(10); SYNC;
#if PROBE == 8
    RUN(9); SYNC; RUN(10); SYNC;
#endif
    RUN(11); SYNC;
#if PROBE == 2
    RUN(9); SYNC; RUN(10); SYNC; RUN(11); SYNC;
#endif
    RUN(12); SYNC; RUN(13); SYNC;
#if PROBE == 6
    RUN(13); SYNC;
#endif
    RUN(14); SYNC; RUN(15); SYNC; RUN(16);
}

extern "C" void kernel_launch(void* const* d_in, const int* in_sizes, int n_in, void* d_out, int out_size, void* d_ws, size_t ws_size, hipStream_t stream) {
    static int grid = 0;
    if (grid == 0) {
        if (n_in != 28 || out_size != MROWS * DM || ws_size < WS_END) { fprintf(stderr, "kernel_launch: unexpected shapes (n_in %d out %d ws %zu)\n", n_in, out_size, ws_size); grid = -1; return; }
        int dev = 0, cus = 0, per_cu = 0;
        (void)hipGetDevice(&dev); (void)hipDeviceGetAttribute(&cus, hipDeviceAttributeMultiprocessorCount, dev);
        if (hipFuncSetAttribute((const void*)mega_fwd, hipFuncAttributeMaxDynamicSharedMemorySize, LDS_BYTES) != hipSuccess) { fprintf(stderr, "kernel_launch: hipFuncSetAttribute failed\n"); grid = -1; return; }
        if (hipOccupancyMaxActiveBlocksPerMultiprocessor(&per_cu, (const void*)mega_fwd, 512, LDS_BYTES) != hipSuccess || per_cu < 1) { fprintf(stderr, "kernel_launch: occupancy query says %d\n", per_cu); per_cu = 1; }
        (void)hipGetLastError();
        grid = cus * 1;
        if (grid <= 0) grid = 256;
    }
    if (grid < 0) return;
    Args a{};
    for (int i = 0; i < 28; ++i) a.in[i] = (const float*)d_in[i];
    a.out = (float*)d_out; a.ws = (unsigned char*)d_ws; a.ph_lo = 0; a.ph_hi = 0;
    if (hipMemsetAsync(d_ws, 0, WS_ZERO_BYTES, stream) != hipSuccess) { fprintf(stderr, "kernel_launch: memset failed\n"); return; }
    void* kargs[] = {&a};
    hipError_t e = hipLaunchCooperativeKernel((const void*)mega_fwd, dim3(grid), dim3(512), kargs, LDS_BYTES, stream);
    if (e != hipSuccess) fprintf(stderr, "kernel_launch: cooperative launch failed: %s (grid %d)\n", hipGetErrorString(e), grid);
}
```

```cpp
#include <hip/hip_runtime.h>
#include <hip/hip_cooperative_groups.h>
#include <cstdio>
#include <cstdint>
namespace cg = cooperative_groups;

#define LAS __attribute__((address_space(3)))
typedef unsigned short bf16_t;
typedef short bf16x8 __attribute__((ext_vector_type(8)));
typedef float f32x4 __attribute__((ext_vector_type(4)));
typedef unsigned u32x4 __attribute__((ext_vector_type(4)));
typedef unsigned u32x2 __attribute__((ext_vector_type(2)));

constexpr int MROWS = 24576, SEQ_P = 8192, DM = 2048, DFF = 5632, DMH = 1024, NHEAD = 8, DH = 128;
constexpr int LDZ = 4096;
constexpr int NZ = 5376;
constexpr int S5NCB = 48;
constexpr int LDZ_OLD_UNUSED = 0;
constexpr int D_IN = 5152;
constexpr int NCH = MROWS / 128;
constexpr int S5T = 32, S5NC = MROWS / S5T;
constexpr float EPS = 1e-6f;

constexpr size_t MiB = 1u << 20;
constexpr size_t WS_UG = 322 * MiB;
constexpr size_t WS_WIN = 1 * MiB, WS_WGLU = 22 * MiB, WS_WOUT = 26 * MiB, WS_XN = 34 * MiB, WS_BIG = 130 * MiB;
constexpr size_t WS_WAD = 394 * MiB, WS_WAGU = 416 * MiB;
constexpr size_t WS_GATES = 382 * MiB, WS_S5E = 385 * MiB, WS_S5W1 = 433 * MiB, WS_S5W3 = 449 * MiB;
constexpr size_t WS_ST = 385 * MiB, WS_NST = 481 * MiB, WS_DEC = 483 * MiB, WS_END = 512 * MiB;
constexpr size_t WS_SS1 = 131072;
constexpr size_t WS_SS3 = 262144;
constexpr size_t WS_SS2 = 393216;
constexpr size_t WS_ZERO_BYTES = 524288;
constexpr size_t WS_XN2 = 130 * MiB, WS_H2 = 226 * MiB, WS_WAGU2 = 1 * MiB, WS_WAD2 = 45 * MiB;

constexpr int LDS_BYTES = 147456;

__device__ __forceinline__ unsigned f2bf(float f) { return (__builtin_bit_cast(unsigned, f) + 0x8000u) >> 16; }
__device__ __forceinline__ unsigned pk2(float lo, float hi) {
    const unsigned ra = __builtin_bit_cast(unsigned, lo) + 0x8000u, rb = __builtin_bit_cast(unsigned, hi) + 0x8000u;
    return __builtin_amdgcn_perm(rb, ra, 0x07060302u);
}
__device__ __forceinline__ float bflo(unsigned v) { return __uint_as_float(v << 16); }
__device__ __forceinline__ float bfhi(unsigned v) { return __uint_as_float(v & 0xffff0000u); }
__device__ __forceinline__ float bf2f(bf16_t v) { return __uint_as_float(((unsigned)v) << 16); }
__device__ __forceinline__ float sigmoid_f(float x) { return __builtin_amdgcn_rcpf(1.f + __expf(-x)); }
__device__ __forceinline__ float silu_f(float x) { return x * sigmoid_f(x); }
__device__ __forceinline__ float logsigmoid_f(float x) { return fminf(x, 0.f) - log1pf(__expf(-fabsf(x))); }
__device__ __forceinline__ float gelu_tanh_f(float x) { const float u = 0.7978845608028654f * (x + 0.044715f * x * x * x); return x * sigmoid_f(2.f * u); }
__device__ __forceinline__ float wave_sum(float v) {
#pragma unroll
    for (int o = 1; o < 64; o <<= 1) v += __shfl_xor(v, o);
    return v;
}
#define MFMA16(a, b, c) __builtin_amdgcn_mfma_f32_16x16x32_bf16((a), (b), (c), 0, 0, 0)

namespace pg8 {
constexpr int BM = 256, BK = 64, HALF = 128, HTB = HALF * BK * 2, STAGE_BYTES = 8 * HTB, NXCD = 8, WGM = 8;
__host__ __device__ __forceinline__ int lds_byte(int r, int c) { const int st = (r >> 4) * 2 + (c >> 5), rr = r & 15, cc = c & 31, ob = rr * 64 + cc * 2; return st * 1024 + (ob ^ (((ob >> 9) & 1) << 5)); }
__host__ __device__ __forceinline__ void stage_rc(int b, int& R, int& C) { const int st = b / 1024, sb = b % 1024, swz = sb ^ (((sb >> 9) & 1) << 5); R = (st >> 1) * 16 + swz / 64; C = (st & 1) * 32 + (swz % 64) / 2; }
__host__ __device__ __forceinline__ int perm32(int rho) { const int n = rho >> 4, i = rho & 15; return 8 * (i >> 2) + 4 * n + (i & 3); }

struct Unit { int pm, pn; };
struct Gemm { const bf16_t* A; const bf16_t* Bt; int M, N, K, lda; };

struct StaticOrder {
    int nM, nN, nwg, G, c;
    __device__ void init(int M, int N, int G_, int c_) { nM = M / BM; nN = N / BM; nwg = nM * nN; G = G_; c = c_; }
    __device__ bool next(int i, Unit& u) const {
        const long L = (long)i * G + c; if (L >= nwg) return false;
        int wgid = (int)L; { const int q = nwg / NXCD, r = nwg % NXCD, xcd = wgid % NXCD, off = wgid / NXCD; wgid = (xcd < r ? xcd * (q + 1) : r * (q + 1) + (xcd - r) * q) + off; }
        const int nig = WGM * nN, gid = wgid / nig, fm = gid * WGM, gsz = (nM - fm) < WGM ? (nM - fm) : WGM;
        u.pm = fm + ((wgid % nig) % gsz); u.pn = (wgid % nig) / gsz; return true;
    }
};

struct EpiSwiglu {
    static constexpr bool PERM = true;
    bf16_t* O; int ldc; int glu; const float* ss;
    __device__ __forceinline__ void operator()(const f32x4 (&acc)[2][2][4][2], const Unit& u, int wr, int wc, int fr, int fq) const {
        const int row0 = u.pm * BM + wr * 64 + fr, col0 = u.pn * HALF + wc * 32 + 8 * fq;
#pragma unroll
        for (int ai = 0; ai < 2; ++ai)
#pragma unroll
            for (int m = 0; m < 4; ++m) {
                bf16_t* rowp = O + (size_t)(row0 + ai * HALF + m * 16) * ldc + col0;
                const float rs = ss ? rsqrtf(ss[row0 + ai * HALF + m * 16] * (1.f / DM) + EPS) : 1.f;
                const f32x4 g0 = acc[ai][0][m][0] * rs, g1 = acc[ai][0][m][1] * rs, u0 = acc[ai][1][m][0] * rs, u1 = acc[ai][1][m][1] * rs;
                float r[8];
#pragma unroll
                for (int i = 0; i < 4; ++i) {
                    r[i] = glu ? g0[i] * sigmoid_f(u0[i]) : silu_f(g0[i]) * u0[i];
                    r[4 + i] = glu ? g1[i] * sigmoid_f(u1[i]) : silu_f(g1[i]) * u1[i];
                }
                u32x4 w; w.x = pk2(r[0], r[1]); w.y = pk2(r[2], r[3]); w.z = pk2(r[4], r[5]); w.w = pk2(r[6], r[7]);
                *(u32x4*)rowp = w;
            }
    }
};
struct EpiResid {
    static constexpr bool PERM = false;
    const float* resA; const float* resB; float* out; int ldc; float scale; bf16_t* xn; const float* wn; float* ss;
    __device__ __forceinline__ void operator()(const f32x4 (&acc)[2][2][4][2], const Unit& u, int wr, int wc, int fr, int fq) const {
        const int row0 = u.pm * BM + wr * 64 + fr, col0 = u.pn * BM + wc * 32 + 4 * fq;
        const float* rbase = (u.pm * BM < SEQ_P) ? resA : (resB - (size_t)SEQ_P * ldc);
        f32x4 wv[2][2];
        if (xn) {
#pragma unroll
            for (int bj = 0; bj < 2; ++bj)
#pragma unroll
                for (int n = 0; n < 2; ++n) wv[bj][n] = *(const f32x4*)(wn + col0 + bj * HALF + n * 16);
        }
#pragma unroll
        for (int ai = 0; ai < 2; ++ai)
#pragma unroll
            for (int m = 0; m < 4; ++m) {
                const int row = row0 + ai * HALF + m * 16;
                const size_t off = (size_t)row * ldc + col0;
                float q = 0.f;
#pragma unroll
                for (int bj = 0; bj < 2; ++bj)
#pragma unroll
                    for (int n = 0; n < 2; ++n) {
                        const f32x4 rv = *(const f32x4*)(rbase + off + bj * HALF + n * 16);
                        const f32x4 v = rv + acc[ai][bj][m][n] * scale;
                        if (out) *(f32x4*)(out + off + bj * HALF + n * 16) = v;
                        if (xn) { q += (v.x * v.x + v.y * v.y) + (v.z * v.z + v.w * v.w); const f32x4 o = v * wv[bj][n];
                            u32x2 p; p.x = pk2(o.x, o.y); p.y = pk2(o.z, o.w); *(u32x2*)(xn + off + bj * HALF + n * 16) = p; }
                    }
                if (xn) { q += __shfl_xor(q, 16); q += __shfl_xor(q, 32); if (fq == 0) (void)__hip_atomic_fetch_add(ss + row, q, __ATOMIC_RELAXED, __HIP_MEMORY_SCOPE_AGENT); }
            }
    }
};
struct EpiZ {
    static constexpr bool PERM = true;
    bf16_t* O; int ldc; float* gates; int gate_pn; const float* ss; bf16_t* ug;
    __device__ __forceinline__ void operator()(const f32x4 (&acc)[2][2][4][2], const Unit& u, int wr, int wc, int fr, int fq) const {
        const int row0 = u.pm * BM + wr * 64 + fr;
        const int kind = (u.pn == gate_pn) ? 2 : (u.pn >= 16 ? 1 : 0);
        if (kind == 2 && wc != 0) return;
#pragma unroll
        for (int ai = 0; ai < 2; ++ai)
#pragma unroll
            for (int m = 0; m < 4; ++m) {
                const int row = row0 + ai * HALF + m * 16;
                const float rs = rsqrtf(ss[row] * (1.f / DM) + EPS);
                if (kind == 2) {
                    float* gp = gates + (size_t)row * 32 + 8 * fq;
                    *(f32x4*)gp = acc[ai][0][m][0] * rs; *(f32x4*)(gp + 4) = acc[ai][0][m][1] * rs;
                } else {
#pragma unroll
                    for (int bj = 0; bj < 2; ++bj) {
                        const f32x4 v0 = acc[ai][bj][m][0] * rs, v1 = acc[ai][bj][m][1] * rs;
                        u32x4 w; w.x = pk2(v0[0], v0[1]); w.y = pk2(v0[2], v0[3]); w.z = pk2(v1[0], v1[1]); w.w = pk2(v1[2], v1[3]);
                        bf16_t* dst;
                        if (kind == 1) { const int chunk = row >> 5, j = row & 31, ucol = (u.pn - 16) * BM + bj * HALF + wc * 32 + 8 * fq, g = ucol >> 4, half = (ucol >> 3) & 1;
                            dst = ug + ((((size_t)(g * S5NCB + (chunk >> 4)) * 32 + j) * 16 + (chunk & 15)) * 16 + half * 8); }
                        else dst = O + (size_t)row * ldc + u.pn * BM + bj * HALF + wc * 32 + 8 * fq;
                        *(u32x4*)dst = w;
                    }
                }
            }
    }
};

template <class Epi, bool ALIGN_EPI>
__device__ __forceinline__ void gemm_phase(LAS unsigned char* lds, const Gemm g, const StaticOrder& S, const Epi& E) {
    int tid_ = threadIdx.x; asm volatile("" : "+v"(tid_));
    const int tid = tid_, wid = __builtin_amdgcn_readfirstlane(tid >> 6), lane = tid & 63, wr = wid >> 2, wc = wid & 3, fr = lane & 15, fq = lane >> 4;
    const int K = g.K, nt = K / BK, lda = g.lda;
    unsigned voffA[2], voffB[2];
#pragma unroll
    for (int i = 0; i < 2; ++i) { int R, C; stage_rc(tid * 16 + i * 8192, R, C); const int Rb = Epi::PERM ? ((R & ~31) + perm32(R & 31)) : R;
        voffA[i] = (unsigned)(R * lda + C) * 2u; voffB[i] = (unsigned)(Rb * K + C) * 2u; }
    const size_t kstep = (size_t)(BK * 2);
    const size_t hstepA = (size_t)HALF * lda * 2, hstepB = (size_t)HALF * K * 2;
    const size_t tstepA = 2 * hstepA, tstepB = 2 * hstepB;
    const unsigned ldsw = (unsigned)wid * 1024u;
    const int aoff = lds_byte(wr * 64 + fr, fq * 8), boff = lds_byte(wc * 32 + fr, fq * 8);
#define PG8_SA(b, h) (((b) * 2 + (h)) * HTB)
#define PG8_SB(b, h) ((4 + (b) * 2 + (h)) * HTB)
#define PG8_STAGE(bufoff, gbase, voff) do { _Pragma("unroll") for (int _i = 0; _i < 2; ++_i) \
        __builtin_amdgcn_global_load_lds((const unsigned*)((const char*)(gbase) + (voff)[_i]), (LAS unsigned*)(lds + (bufoff) + ldsw + _i * 8192), 16, 0, 0); } while (0)
#define PG8_LDA(dst, b, h) do { _Pragma("unroll") for (int m = 0; m < 4; ++m) _Pragma("unroll") for (int k = 0; k < 2; ++k) dst[m][k] = *(const LAS bf16x8*)(lds + PG8_SA(b, h) + aoff + m * 2048 + k * 1024); } while (0)
#define PG8_LDB(dst, b, h) do { _Pragma("unroll") for (int n = 0; n < 2; ++n) _Pragma("unroll") for (int k = 0; k < 2; ++k) dst[n][k] = *(const LAS bf16x8*)(lds + PG8_SB(b, h) + boff + n * 2048 + k * 1024); } while (0)
#define PG8_MMA(ai, bj, At, Bt) do { __builtin_amdgcn_s_setprio(1); _Pragma("unroll") for (int m = 0; m < 4; ++m) _Pragma("unroll") for (int n = 0; n < 2; ++n) _Pragma("unroll") for (int k = 0; k < 2; ++k) \
        acc[ai][bj][m][n] = __builtin_amdgcn_mfma_f32_16x16x32_bf16(Bt[n][k], At[m][k], acc[ai][bj][m][n], 0, 0, 0); __builtin_amdgcn_s_setprio(0); } while (0)
#define PG8_WAIT_V(n) asm volatile("s_waitcnt vmcnt(" #n ")" ::: "memory")
#define PG8_WAIT_L(n) asm volatile("s_waitcnt lgkmcnt(" #n ")" ::: "memory")
#define PG8_BAR __builtin_amdgcn_s_barrier()
#define PG8_SCHED __builtin_amdgcn_sched_barrier(0)
    Unit cur, nxt; int ui = 0;
    if (!S.next(0, cur)) return;
    f32x4 acc[2][2][4][2];
#pragma unroll
    for (int a = 0; a < 2; ++a)
#pragma unroll
        for (int b = 0; b < 2; ++b)
#pragma unroll
            for (int m = 0; m < 4; ++m)
#pragma unroll
                for (int n = 0; n < 2; ++n) acc[a][b][m][n] = (f32x4){0.f, 0.f, 0.f, 0.f};
    bf16x8 At[4][2], B0[2][2], B1[2][2];
    const char* cA = (const char*)g.A + (size_t)cur.pm * tstepA; const char* cB = (const char*)g.Bt + (size_t)cur.pn * tstepB;
    PG8_STAGE(PG8_SB(0, 0), cB, voffB); PG8_STAGE(PG8_SB(0, 1), cB + hstepB, voffB); PG8_STAGE(PG8_SA(0, 0), cA, voffA); PG8_STAGE(PG8_SA(0, 1), cA + hstepA, voffA);
    if (wr == 1) PG8_BAR;
    PG8_WAIT_V(2); PG8_BAR;
    PG8_STAGE(PG8_SB(1, 0), cB + kstep, voffB); PG8_STAGE(PG8_SA(1, 0), cA + kstep, voffA); PG8_STAGE(PG8_SB(1, 1), cB + hstepB + kstep, voffB);
    PG8_WAIT_V(6); PG8_BAR;
    for (;;) {
        const bool has_next = S.next(ui + 1, nxt);
        const char* nA = has_next ? (const char*)g.A + (size_t)nxt.pm * tstepA : cA; const char* nB = has_next ? (const char*)g.Bt + (size_t)nxt.pn * tstepB : cB;
        for (int t = 0; t < nt; t += 2) {
            const bool last = (t == nt - 2);
            const char* a1 = cA + (size_t)(t + 1) * kstep;
            const char* a2 = last ? nA : cA + (size_t)(t + 2) * kstep; const char* b2 = last ? nB : cB + (size_t)(t + 2) * kstep;
            const char* a3 = a2 + kstep; const char* b3 = b2 + kstep;
            PG8_LDB(B0, 0, 0); PG8_LDB(B1, 0, 1); PG8_SCHED; PG8_LDA(At, 0, 0); PG8_STAGE(PG8_SA(1, 1), a1 + hstepA, voffA);
            PG8_WAIT_V(8); PG8_WAIT_L(0); PG8_BAR; PG8_MMA(0, 0, At, B0); PG8_MMA(0, 1, At, B1); PG8_BAR; PG8_SCHED;
            PG8_LDA(At, 0, 1); PG8_STAGE(PG8_SB(0, 0), b2, voffB); PG8_STAGE(PG8_SB(0, 1), b2 + hstepB, voffB); PG8_STAGE(PG8_SA(0, 0), a2, voffA);
            PG8_WAIT_V(8); PG8_WAIT_L(0); PG8_BAR; PG8_MMA(1, 0, At, B0); PG8_MMA(1, 1, At, B1); PG8_BAR; PG8_SCHED;
            PG8_LDB(B0, 1, 0); PG8_LDB(B1, 1, 1); PG8_SCHED; PG8_LDA(At, 1, 0); PG8_STAGE(PG8_SA(0, 1), a2 + hstepA, voffA);
            PG8_WAIT_V(8); PG8_WAIT_L(0); PG8_BAR; PG8_MMA(0, 0, At, B0); PG8_MMA(0, 1, At, B1); PG8_BAR; PG8_SCHED;
            PG8_LDA(At, 1, 1); PG8_STAGE(PG8_SB(1, 0), b3, voffB); PG8_STAGE(PG8_SB(1, 1), b3 + hstepB, voffB); PG8_STAGE(PG8_SA(1, 0), a3, voffA);
            PG8_WAIT_V(8); PG8_WAIT_L(0); PG8_BAR; PG8_MMA(1, 0, At, B0); PG8_MMA(1, 1, At, B1); PG8_BAR; PG8_SCHED;
        }
        if constexpr (ALIGN_EPI) { if (wr == 0) PG8_BAR; }
        E(acc, cur, wr, wc, fr, fq);
        if (!has_next) break;
#pragma unroll
        for (int a = 0; a < 2; ++a)
#pragma unroll
            for (int b = 0; b < 2; ++b)
#pragma unroll
                for (int m = 0; m < 4; ++m)
#pragma unroll
                    for (int n = 0; n < 2; ++n) acc[a][b][m][n] = (f32x4){0.f, 0.f, 0.f, 0.f};
        cur = nxt; cA = nA; cB = nB; ++ui;
        if constexpr (ALIGN_EPI) { if (wr == 1) PG8_BAR; }
    }
    PG8_WAIT_V(0);
    if constexpr (!ALIGN_EPI) { if (wr == 0) PG8_BAR; }
    PG8_BAR;
#undef PG8_SA
#undef PG8_SB
#undef PG8_STAGE
#undef PG8_LDA
#undef PG8_LDB
#undef PG8_MMA
#undef PG8_WAIT_V
#undef PG8_WAIT_L
#undef PG8_BAR
#undef PG8_SCHED
}
}

__device__ __forceinline__ int rowmap(int mode, int n0) {
    switch (mode) {
        case 1: return (n0 >> 7) * 256 + (n0 & 127);
        case 2: return (n0 >> 7) * 256 + 128 + (n0 & 127);
        case 3: return n0 < 4096 ? n0 : (n0 < 4128 ? 5120 + (n0 - 4096) : n0 - 32);
        case 4: return n0 < 1024 ? ((n0 >> 7) * 256 + (n0 & 127)) : ((((n0 - 1024) >> 7) * 256) + 128 + ((n0 - 1024) & 127));
        default: return n0;
    }
}
__device__ __forceinline__ void transpose_item(const float* W, int K, int N, bf16_t* WT, int mode, int item, int lane) {
    const int nblk = N / 32, kb = item / nblk, nb = item % nblk, k0 = 128 * kb, n0 = 32 * nb;
    const int drow = rowmap(mode, n0), lq = lane >> 3, lc = lane & 7;
    const float* src = W + (size_t)(k0 + lq * 8) * N + n0 + 4 * lc;
    f32x4 v[16];
#pragma unroll
    for (int i = 0; i < 8; ++i) { v[i] = *(const f32x4*)(src + (size_t)i * N); v[8 + i] = *(const f32x4*)(src + (size_t)(64 + i) * N); }
    bf16_t* dst = WT + (size_t)(drow + 4 * lc) * K + k0 + lq * 8;
#pragma unroll
    for (int c = 0; c < 4; ++c) {
        u32x4 o0, o1;
        o0.x = pk2(v[0][c], v[1][c]); o0.y = pk2(v[2][c], v[3][c]); o0.z = pk2(v[4][c], v[5][c]); o0.w = pk2(v[6][c], v[7][c]);
        o1.x = pk2(v[8][c], v[9][c]); o1.y = pk2(v[10][c], v[11][c]); o1.z = pk2(v[12][c], v[13][c]); o1.w = pk2(v[14][c], v[15][c]);
        *(u32x4*)(dst + (size_t)c * K) = o0; *(u32x4*)(dst + (size_t)c * K + 64) = o1;
    }
}
__device__ __forceinline__ void convert_ffn(const float* wg, const float* wu, const float* wd, bf16_t* WAgu, bf16_t* WAd, int gw, int NGW, int lane, int parts = 3) {
    constexpr int I_G = (DM / 128) * (DFF / 32), I_D = (DFF / 128) * (DM / 32);
    const int lo = (parts & 1) ? 0 : 2 * I_G, hi = (parts & 2) ? 2 * I_G + I_D : 2 * I_G;
    for (int it = lo + gw; it < hi; it += NGW) {
        int r = it;
        if (r < I_G) { transpose_item(wg, DM, DFF, WAgu, 1, r, lane); continue; } r -= I_G;
        if (r < I_G) { transpose_item(wu, DM, DFF, WAgu, 2, r, lane); continue; } r -= I_G;
        transpose_item(wd, DFF, DM, WAd, 0, r, lane);
    }
}
__device__ __forceinline__ void convert_small(const float* win, const float* wglu, const float* wout, bf16_t* Win_t, bf16_t* Wglu_t, bf16_t* Wout_t, int gw, int NGW, int lane) {
    constexpr int I_IN = (DM / 128) * (D_IN / 32), I_GLU = (DMH / 128) * (DM / 32), I_OUT = (DM / 128) * (DM / 32);
    for (int it = gw; it < I_IN + I_GLU + I_OUT; it += NGW) {
        int r = it;
        if (r < I_IN) { transpose_item(win, DM, D_IN, Win_t, 3, r, lane); continue; } r -= I_IN;
        if (r < I_GLU) { transpose_item(wglu, DMH, DM, Wglu_t, 4, r, lane); continue; } r -= I_GLU;
        transpose_item(wout, DM, DM, Wout_t, 0, r, lane);
    }
}
__device__ __forceinline__ void rms_rows_bf16(const float* srcA, const float* srcB, const float* w, bf16_t* dst, int gw, int NGW, int lane) {
    for (int m = gw; m < MROWS; m += NGW) {
        const float* src = (m < SEQ_P) ? srcA + (size_t)m * DM : srcB + (size_t)(m - SEQ_P) * DM;
        f32x4 v[8]; float s = 0.f;
#pragma unroll
        for (int j = 0; j < 8; ++j) { v[j] = ((const f32x4*)src)[lane + 64 * j]; s += (v[j].x * v[j].x + v[j].y * v[j].y) + (v[j].z * v[j].z + v[j].w * v[j].w); }
        const float rs = rsqrtf(wave_sum(s) * (1.f / DM) + EPS);
#pragma unroll
        for (int j = 0; j < 8; ++j) { const f32x4 wv = ((const f32x4*)w)[lane + 64 * j]; const f32x4 o = v[j] * rs * wv;
            u32x2 p; p.x = pk2(o.x, o.y); p.y = pk2(o.z, o.w); ((u32x2*)(dst + (size_t)m * DM))[lane + 64 * j] = p; }
    }
}
__device__ __forceinline__ void final_scale_rows(const bf16_t* xw, const float* ss, float* y, int gw, int NGW, int lane) {
    for (int m = gw; m < MROWS; m += NGW) {
        const u32x2* src = (const u32x2*)(xw + (size_t)m * DM);
        u32x2 v[8];
#pragma unroll
        for (int j = 0; j < 8; ++j) v[j] = src[lane + 64 * j];
        const float rs = rsqrtf(ss[m] * (1.f / DM) + EPS);
        f32x4* dst = (f32x4*)(y + (size_t)m * DM);
#pragma unroll
        for (int j = 0; j < 8; ++j) dst[lane + 64 * j] = (f32x4){bflo(v[j].x) * rs, bfhi(v[j].x) * rs, bflo(v[j].y) * rs, bfhi(v[j].y) * rs};
    }
}
__device__ __forceinline__ void rms_rows_f32_inplace(float* x, const float* w, int gw, int NGW, int lane) {
    for (int m = gw; m < MROWS; m += NGW) {
        float* src = x + (size_t)m * DM;
        f32x4 v[8]; float s = 0.f;
#pragma unroll
        for (int j = 0; j < 8; ++j) { v[j] = ((const f32x4*)src)[lane + 64 * j]; s += (v[j].x * v[j].x + v[j].y * v[j].y) + (v[j].z * v[j].z + v[j].w * v[j].w); }
        const float rs = rsqrtf(wave_sum(s) * (1.f / DM) + EPS);
#pragma unroll
        for (int j = 0; j < 8; ++j) { const f32x4 wv = ((const f32x4*)w)[lane + 64 * j]; ((f32x4*)src)[lane + 64 * j] = v[j] * rs * wv; }
    }
}

__device__ __forceinline__ void s5_gen(LAS unsigned char* lds, const float* a_re, const float* a_im, const float* log_dt, const float* b_re, const float* b_im,
                                       const float* c_re, const float* c_im, const float* dskip, bf16_t* W1, bf16_t* W3, int g, int part, int tid) {
    LAS float* pw = (LAS float*)lds;
    LAS float* bb = pw + 4 * 33 * 64;
    LAS float* kt = bb + 4 * 1024;
    LAS bf16_t* bt = (LAS bf16_t*)(kt + 2 * 32 * 256);
#define PW(dir, ri, d, p) pw[(((dir) * 2 + (ri)) * 33 + (d)) * 64 + (p)]
#define BB(dir, ri, p, ch) bb[(((dir) * 2 + (ri)) * 64 + (p)) * 16 + (ch)]
#define KT(dir, d, e) kt[((dir) * 32 + (d)) * 256 + (e)]
    {
        const int dir = tid >> 8, p = (tid >> 2) & 63, dq = tid & 3;
        const float are = a_re[dir * 4096 + g * 64 + p], aim = a_im[dir * 4096 + g * 64 + p], dt = __expf(log_dt[dir * 64 + g]);
        const float xr = are * dt, xi = aim * dt;
        for (int d = dq; d <= 32; d += 4) { const float mag = expf((float)d * xr); float sn, cs; sincosf((float)d * xi, &sn, &cs); PW(dir, 0, d, p) = mag * cs; PW(dir, 1, d, p) = mag * sn; }
        if (dq == 0) {
            float sn, cs, sh; sincosf(xi, &sn, &cs); sh = sinf(0.5f * xi);
            const float nr = expm1f(xr) * cs - 2.f * sh * sh, ni = expf(xr) * sn;
            const float den = 1.f / (are * are + aim * aim);
            const float cr = (nr * are + ni * aim) * den, ci = (ni * are - nr * aim) * den;
            const float* br = b_re + ((size_t)(dir * 64 + g) * 64 + p) * 16; const float* bi = b_im + ((size_t)(dir * 64 + g) * 64 + p) * 16;
            for (int ch = 0; ch < 16; ++ch) { const float x = br[ch], y = bi[ch], zr = cr * x - ci * y, zi = cr * y + ci * x;
                BB(dir, 0, p, ch) = zr; BB(dir, 1, p, ch) = zi; bt[(dir * 16 + ch) * 136 + p] = (bf16_t)f2bf(zr); bt[(dir * 16 + ch) * 136 + 64 + p] = (bf16_t)f2bf(zi); }
        }
    }
    __syncthreads();
    {
        const int wid = tid >> 6, lane = tid & 63, fr = lane & 15, fq = lane >> 4;
        const int nf = 8 * part + 8;
        for (int s = wid; s < 40; s += 8) {
            const int dir = s < nf ? 0 : 1, d = s < nf ? s : s - nf;
            const float* cr = c_re + ((size_t)(dir * 64 + g) * 16 + fr) * 64; const float* ci = c_im + ((size_t)(dir * 64 + g) * 16 + fr) * 64;
            f32x4 acc = (f32x4){0.f, 0.f, 0.f, 0.f};
#pragma unroll
            for (int kk = 0; kk < 4; ++kk) {
                const int p0 = (kk & 1) * 32 + fq * 8;
                float av[8];
#pragma unroll
                for (int i = 0; i < 8; ++i) { const float c0 = cr[p0 + i], c1 = ci[p0 + i], pr = PW(dir, 0, d, p0 + i), pi = PW(dir, 1, d, p0 + i);
                    av[i] = (kk < 2) ? (c0 * pr - c1 * pi) : -(c0 * pi + c1 * pr); }
                u32x4 aw; aw.x = pk2(av[0], av[1]); aw.y = pk2(av[2], av[3]); aw.z = pk2(av[4], av[5]); aw.w = pk2(av[6], av[7]);
                const bf16x8 b = *(const LAS bf16x8*)(bt + (dir * 16 + fr) * 136 + kk * 32 + fq * 8);
                acc = MFMA16(__builtin_bit_cast(bf16x8, aw), b, acc);
            }
#pragma unroll
            for (int jj = 0; jj < 4; ++jj) KT(dir, d, (fq * 4 + jj) * 16 + fr) = acc[jj];
        }
    }
    __syncthreads();
    for (int e = tid; e < 64 * 64; e += 512) {
        const int n = part * 64 + (e >> 6), k8 = (e & 63) * 8, dir = n >> 7, ri = (n >> 6) & 1, p = n & 63, j = k8 >> 4, ch0 = k8 & 15;
        const int d = dir ? j : (31 - j);
        const float pr = PW(dir, 0, d, p), pi = PW(dir, 1, d, p);
        float v[8];
#pragma unroll
        for (int i = 0; i < 8; ++i) { const float x = BB(dir, 0, p, ch0 + i), y = BB(dir, 1, p, ch0 + i); v[i] = ri ? (pr * y + pi * x) : (pr * x - pi * y); }
        u32x4 o; o.x = pk2(v[0], v[1]); o.y = pk2(v[2], v[3]); o.z = pk2(v[4], v[5]); o.w = pk2(v[6], v[7]);
        *(u32x4*)(W1 + (size_t)n * 512 + k8) = o;
    }
    for (int e = tid; e < 128 * 96; e += 512) {
        const int n = part * 128 + e / 96, k8 = (e % 96) * 8, j = n >> 4, ch = n & 15;
        float v[8];
        if (k8 < 512) {
            const int j2 = k8 >> 4, ch0 = k8 & 15;
#pragma unroll
            for (int i = 0; i < 8; ++i) {
                float s = 0.f;
                if (j2 <= j) s += KT(0, j - j2, ch * 16 + ch0 + i);
                if (j2 >= j) s += KT(1, j2 - j, ch * 16 + ch0 + i);
                if (j2 == j && ch0 + i == ch) s += dskip[g * 16 + ch];
                v[i] = s;
            }
        } else {
            const int kk = k8 - 512, dir = kk >> 7, ri = (kk >> 6) & 1, p0 = kk & 63;
            const int d = dir ? (32 - j) : (j + 1);
            const float* cr = c_re + ((size_t)(dir * 64 + g) * 16 + ch) * 64 + p0; const float* ci = c_im + ((size_t)(dir * 64 + g) * 16 + ch) * 64 + p0;
#pragma unroll
            for (int i = 0; i < 8; ++i) { const float pr = PW(dir, 0, d, p0 + i), pi = PW(dir, 1, d, p0 + i), c0 = cr[i], c1 = ci[i];
                v[i] = ri ? -(c0 * pi + c1 * pr) : (c0 * pr - c1 * pi); }
        }
        u32x4 o; o.x = pk2(v[0], v[1]); o.y = pk2(v[2], v[3]); o.z = pk2(v[4], v[5]); o.w = pk2(v[6], v[7]);
        *(u32x4*)(W3 + (size_t)n * 768 + k8) = o;
    }
    __syncthreads();
#undef PW
#undef BB
#undef KT
}
__device__ __forceinline__ void s5_egemm(LAS unsigned char* lds, const bf16_t* Z, const bf16_t* W1, float* E, int unit, int tid) {
    const int nh = unit & 3, mb3 = (unit >> 2) % 3, g = unit / 12;
    const int wid = tid >> 6, lane = tid & 63, fr = lane & 15, fq = lane >> 4;
    const int cbase = mb3 * 256 + wid * 32;
    f32x4 acc[2][4];
#pragma unroll
    for (int m = 0; m < 2; ++m)
#pragma unroll
        for (int n = 0; n < 4; ++n) acc[m][n] = (f32x4){0.f, 0.f, 0.f, 0.f};
    const bf16_t* Ab = Z + ((size_t)(g * S5NCB + (cbase >> 4)) * 32 + (fq >> 1)) * 256 + fr * 16 + (fq & 1) * 8;
    const bf16_t* Bsrc = W1 + (size_t)g * 256 * 512 + (size_t)(nh * 64 + (tid >> 3)) * 512 + (tid & 7) * 8;
    constexpr int ROWB = 144, BUFB = 64 * ROWB;
    LAS unsigned char* bdst = lds + (tid >> 3) * ROWB + (tid & 7) * 16;
    const LAS unsigned char* brd = lds + fr * ROWB + fq * 16;
    u32x4 rb[5]; bf16x8 af[5][4];
#define S5E_LOAD(slot, it) do { rb[slot] = *(const u32x4*)(Bsrc + (it) * 64); \
        _Pragma("unroll") for (int ks = 0; ks < 2; ++ks) _Pragma("unroll") for (int m = 0; m < 2; ++m) af[slot][ks * 2 + m] = *(const bf16x8*)(Ab + m * 8192 + (2 * (it) + ks) * 512); } while (0)
#define S5E_BAR() do { asm volatile("s_waitcnt lgkmcnt(0)" ::: "memory"); __builtin_amdgcn_s_barrier(); asm volatile("" ::: "memory"); } while (0)
    S5E_LOAD(0, 0); S5E_LOAD(1, 1); S5E_LOAD(2, 2); S5E_LOAD(3, 3);
    *(LAS u32x4*)bdst = rb[0];
    S5E_BAR();
#pragma unroll
    for (int it = 0; it < 8; ++it) {
        if (it + 4 < 8) S5E_LOAD((it + 4) % 5, it + 4);
        const LAS unsigned char* rbuf = brd + (it & 1) * BUFB;
#pragma unroll
        for (int ks = 0; ks < 2; ++ks)
#pragma unroll
            for (int n = 0; n < 4; ++n) { const bf16x8 bf = *(const LAS bf16x8*)(rbuf + n * 16 * ROWB + ks * 64);
#pragma unroll
                for (int m = 0; m < 2; ++m) acc[m][n] = MFMA16(bf, af[it % 5][ks * 2 + m], acc[m][n]); }
        if (it + 1 < 8) *(LAS u32x4*)(bdst + ((it + 1) & 1) * BUFB) = rb[(it + 1) % 5];
        S5E_BAR();
    }
#undef S5E_LOAD
#undef S5E_BAR
#pragma unroll
    for (int m = 0; m < 2; ++m)
#pragma unroll
        for (int n = 0; n < 4; ++n)
            *(f32x4*)(E + (size_t)(cbase + m * 16 + fr) * 16384 + g * 256 + nh * 64 + n * 16 + fq * 4) = acc[m][n];
}
__device__ __forceinline__ void s5_scan(float* E, const float* a_re, const float* a_im, const float* log_dt, int task) {
    const int p = task & 63, dir = (task >> 6) & 1, g = (task >> 7) & 63, seq = task >> 13;
    const float are = a_re[dir * 4096 + g * 64 + p], aim = a_im[dir * 4096 + g * 64 + p], dt = __expf(log_dt[dir * 64 + g]);
    const float mag = expf(32.f * are * dt); float sn, cs; sincosf(32.f * aim * dt, &sn, &cs);
    const float lr = mag * cs, li = mag * sn;
    const int clo = seq ? 256 : 0, chi = seq ? 768 : 256, nc = chi - clo;
    float xr = 0.f, xi = 0.f;
    const long cstep = dir ? -16384 : 16384;
    float* q = E + (size_t)g * 256 + dir * 128 + p + (size_t)(dir ? (chi - 1) : clo) * 16384;
    bf16_t* qb = (bf16_t*)(E + (size_t)g * 256 + (size_t)(dir ? (chi - 1) : clo) * 16384) + dir * 256 + p;
#pragma unroll 1
    for (int i0 = 0; i0 < nc; i0 += 16) {
        float er[16], ei[16];
#pragma unroll
        for (int k = 0; k < 16; ++k) { er[k] = q[k * cstep]; ei[k] = q[k * cstep + 64]; }
#pragma unroll
        for (int k = 0; k < 16; ++k) {
            qb[k * cstep * 2] = (bf16_t)f2bf(xr); qb[k * cstep * 2 + 64] = (bf16_t)f2bf(xi);
            const float nr = lr * xr - li * xi + er[k], ni = lr * xi + li * xr + ei[k];
            xr = nr; xi = ni;
        }
        q += 16 * cstep; qb += 32 * cstep;
    }
}
__device__ __forceinline__ bf16x8 s5_ya(const bf16_t* Ab, const bf16_t* Xb, int m, int kk) {
    if (kk < 16) return *(const bf16x8*)(Ab + m * 8192 + kk * 512);
    const int k0 = (kk - 16) * 32;
    return *(const bf16x8*)(Xb + (size_t)m * 16 * 32768 + (k0 >> 7) * 256 + (k0 & 127));
}
__device__ __forceinline__ void s5_ygemm(LAS unsigned char* lds, const bf16_t* Z, const bf16_t* W3, const float* E, bf16_t* YG, int unit, int tid) {
    const int nq = unit & 3, mb3 = (unit >> 2) % 3, g = unit / 12;
    const int wid = tid >> 6, lane = tid & 63, fr = lane & 15, fq = lane >> 4;
    const int cbase = mb3 * 256 + wid * 32;
    f32x4 acc[2][8];
#pragma unroll
    for (int m = 0; m < 2; ++m)
#pragma unroll
        for (int n = 0; n < 8; ++n) acc[m][n] = (f32x4){0.f, 0.f, 0.f, 0.f};
    const bf16_t* Ab = Z + ((size_t)(g * S5NCB + (cbase >> 4)) * 32 + (fq >> 1)) * 256 + fr * 16 + (fq & 1) * 8;
    const bf16_t* Xb = (const bf16_t*)(E + (size_t)(cbase + fr) * 16384 + g * 256) + fq * 8;
    const bf16_t* Bsrc = W3 + (size_t)g * 512 * 768 + (size_t)(nq * 128 + (tid >> 3)) * 768 + (tid & 7) * 8;
    constexpr int ROWB = 144, BUFB = 128 * ROWB;
    LAS unsigned char* bdst = lds + (tid >> 3) * ROWB + (tid & 7) * 16;
    const LAS unsigned char* brd = lds + fr * ROWB + fq * 16;
    u32x4 rb[5][2]; bf16x8 af[5][4];
#define S5Y_LOAD(slot, it) do { rb[slot][0] = *(const u32x4*)(Bsrc + (it) * 64); rb[slot][1] = *(const u32x4*)(Bsrc + (size_t)64 * 768 + (it) * 64); \
        _Pragma("unroll") for (int ks = 0; ks < 2; ++ks) _Pragma("unroll") for (int m = 0; m < 2; ++m) af[slot][ks * 2 + m] = s5_ya(Ab, Xb, m, 2 * (it) + ks); } while (0)
#define S5Y_PUT(slot, buf) do { *(LAS u32x4*)(bdst + (buf) * BUFB) = rb[slot][0]; *(LAS u32x4*)(bdst + (buf) * BUFB + 64 * ROWB) = rb[slot][1]; } while (0)
#define S5Y_BAR() do { asm volatile("s_waitcnt lgkmcnt(0)" ::: "memory"); __builtin_amdgcn_s_barrier(); asm volatile("" ::: "memory"); } while (0)
    S5Y_LOAD(0, 0); S5Y_LOAD(1, 1); S5Y_LOAD(2, 2); S5Y_LOAD(3, 3);
    S5Y_PUT(0, 0);
    S5Y_BAR();
#pragma unroll
    for (int it = 0; it < 12; ++it) {
        if (it + 4 < 12) S5Y_LOAD((it + 4) % 5, it + 4);
        const LAS unsigned char* rbuf = brd + (it & 1) * BUFB;
#pragma unroll
        for (int ks = 0; ks < 2; ++ks)
#pragma unroll
            for (int n = 0; n < 8; ++n) { const bf16x8 bf = *(const LAS bf16x8*)(rbuf + n * 16 * ROWB + ks * 64);
#pragma unroll
                for (int m = 0; m < 2; ++m) acc[m][n] = MFMA16(bf, af[it % 5][ks * 2 + m], acc[m][n]); }
        if (it + 1 < 12) S5Y_PUT((it + 1) % 5, (it + 1) & 1);
        S5Y_BAR();
    }
#undef S5Y_LOAD
#undef S5Y_PUT
#undef S5Y_BAR
#pragma unroll
    for (int m = 0; m < 2; ++m)
#pragma unroll
        for (int n = 0; n < 8; ++n)
        {
            const int tok = (cbase + m * 16 + fr) * S5T + nq * 8 + n; const f32x4 v = acc[m][n];
            u32x2 w; w.x = pk2(gelu_tanh_f(v[0]), gelu_tanh_f(v[1])); w.y = pk2(gelu_tanh_f(v[2]), gelu_tanh_f(v[3]));
            *(u32x2*)(YG + (size_t)tok * DM + g * 16 + fq * 4) = w;
        }
}

constexpr int LROW = 136;
__device__ __forceinline__ void unpack8(const u32x4 v, float (&f)[8]) {
    f[0] = bflo(v.x); f[1] = bfhi(v.x); f[2] = bflo(v.y); f[3] = bfhi(v.y); f[4] = bflo(v.z); f[5] = bfhi(v.z); f[6] = bflo(v.w); f[7] = bfhi(v.w);
}
constexpr int TRSZ = 128 * 272 + 16 * 16;
__device__ __forceinline__ int tr_piece(int e, int p) { return e * 272 + (e >> 3) * 16 + p * 16; }
#define TR_ST(img, e, s, val) (*(LAS bf16_t*)((LAS unsigned char*)(img) + tr_piece((e), (s) >> 3) + ((s) & 7) * 2) = (bf16_t)(val))
#define TR_LD8(img, e, p) (*(const LAS bf16x8*)((const LAS unsigned char*)(img) + tr_piece((e), (p))))
struct ConvW { f32x4 w0a, w0b, w1a, w1b, w2a, w2b, ba, bb; };
__device__ __forceinline__ ConvW load_convw(const float* conv_w, const float* conv_b, int cch) {
    ConvW w; w.w0a = *(const f32x4*)(conv_w + cch); w.w0b = *(const f32x4*)(conv_w + cch + 4);
    w.w1a = *(const f32x4*)(conv_w + 2048 + cch); w.w1b = *(const f32x4*)(conv_w + 2048 + cch + 4);
    w.w2a = *(const f32x4*)(conv_w + 4096 + cch); w.w2b = *(const f32x4*)(conv_w + 4096 + cch + 4);
    w.ba = *(const f32x4*)(conv_b + cch); w.bb = *(const f32x4*)(conv_b + cch + 4); return w;
}
__device__ __forceinline__ void conv8r(const u32x4 c0, const u32x4 c1, const u32x4 c2, const ConvW& w, float scale, float (&o)[8]) {
    float x0[8], x1[8], x2[8]; unpack8(c0, x0); unpack8(c1, x1); unpack8(c2, x2);
#pragma unroll
    for (int i = 0; i < 4; ++i) {
        o[i] = silu_f(x0[i] * w.w0a[i] + x1[i] * w.w1a[i] + x2[i] * w.w2a[i] + w.ba[i]) * scale;
        o[4 + i] = silu_f(x0[4 + i] * w.w0b[i] + x1[4 + i] * w.w1b[i] + x2[4 + i] * w.w2b[i] + w.bb[i]) * scale;
    }
}
__device__ __forceinline__ void load3(const bf16_t* Z, int row, int seq_lo, int seq_hi, int zcol, u32x4& c0, u32x4& c1, u32x4& c2) {
    const bf16_t* zp = Z + (size_t)row * LDZ + zcol; const u32x4 zero = (u32x4){0u, 0u, 0u, 0u};
    c1 = *(const u32x4*)zp;
    c0 = (row - 1 >= seq_lo) ? *(const u32x4*)(zp - LDZ) : zero;
    c2 = (row + 1 < seq_hi) ? *(const u32x4*)(zp + LDZ) : zero;
}
__device__ __forceinline__ void mlstm_gates_load(const float* G, int r0, int h, int tid, float (&gv)[4]) {
    gv[0] = 0.f; gv[1] = 0.f; gv[2] = 0.f; gv[3] = 0.f;
    if (tid < 128) { const float* gp = G + (size_t)(r0 + tid) * 32; gv[0] = gp[h]; gv[1] = gp[8 + h]; gv[2] = gp[16 + h]; gv[3] = gp[24 + h]; }
}
__device__ __forceinline__ void mlstm_gates_compute(LAS float* fl, const float (&gv)[4], const float* b_i, const float* b_f, int h, int tid) {
    LAS float* igf = fl + 256, *igb = fl + 384, *cf = fl + 512, *cb = fl + 640, *tot = fl + 768, *wt = fl + 776;
    const int lane = tid & 63, w = tid >> 6;
    float sf = 0.f, sb = 0.f, lb = 0.f;
    if (tid < 128) {
        igf[tid] = gv[0] + b_i[h]; igb[tid] = gv[1] + b_i[8 + h];
        sf = logsigmoid_f(gv[2] + b_f[h]); lb = logsigmoid_f(gv[3] + b_f[8 + h]); sb = lb;
#pragma unroll
        for (int o = 1; o < 64; o <<= 1) { const float yf = __shfl_up(sf, o), yb = __shfl_up(sb, o); if (lane >= o) { sf += yf; sb += yb; } }
        if (lane == 63) { wt[w * 2] = sf; wt[w * 2 + 1] = sb; }
    }
    __syncthreads();
    if (tid < 128) { const float of = w ? wt[0] : 0.f, ob = w ? wt[1] : 0.f; cf[tid] = sf + of; cb[tid] = sb - lb + ob;
        if (tid == 0) { tot[0] = wt[0] + wt[2]; tot[1] = wt[1] + wt[3]; } }
    __syncthreads();
}
__device__ __forceinline__ void mlstm_passA(LAS unsigned char* lds, const bf16_t* Z, const float* G, const float* conv_w, const float* conv_b, const float* b_i, const float* b_f,
                                            bf16_t* ST, float* NST, float* DEC, int unit, int tid) {
    const int c = unit >> 3, h = unit & 7, r0 = c * 128;
    const int seq_lo = r0 < SEQ_P ? 0 : SEQ_P, seq_hi = r0 < SEQ_P ? SEQ_P : MROWS;
    LAS bf16_t* Kt = (LAS bf16_t*)lds; LAS bf16_t* Vt = (LAS bf16_t*)(lds + TRSZ);
    LAS float* fl = (LAS float*)(lds + 104704);
    LAS float* igf = fl + 256, *igb = fl + 384, *cf = fl + 512, *cb = fl + 640, *tot = fl + 768, *wf = fl + 896, *wb = fl + 1024;
    const int wid = tid >> 6, lane = tid & 63, fr = lane & 15, fq = lane >> 4;
    float gv[4]; mlstm_gates_load(G, r0, h, tid, gv);
    {
        const int d0 = (tid & 15) * 8, kcol = 1024 + h * 128 + d0;
        const ConvW cw = load_convw(conv_w, conv_b, kcol);
        u32x4 k0[4], k1[4], k2[4], vr[4];
#pragma unroll
        for (int it = 0; it < 4; ++it) { const int row = r0 + (tid >> 4) + 32 * it; load3(Z, row, seq_lo, seq_hi, kcol, k0[it], k1[it], k2[it]); vr[it] = *(const u32x4*)(Z + (size_t)row * LDZ + 2048 + h * 128 + d0); }
#pragma unroll
        for (int it = 0; it < 4; ++it) {
            const int s = (tid >> 4) + 32 * it;
            float kv[8]; conv8r(k0[it], k1[it], k2[it], cw, 1.f, kv);
            const u32x4 v = vr[it];
#pragma unroll
            for (int i = 0; i < 8; ++i) TR_ST(Kt, d0 + i, s, f2bf(kv[i]));
            TR_ST(Vt, d0 + 0, s, v.x & 0xffffu); TR_ST(Vt, d0 + 1, s, v.x >> 16); TR_ST(Vt, d0 + 2, s, v.y & 0xffffu); TR_ST(Vt, d0 + 3, s, v.y >> 16);
            TR_ST(Vt, d0 + 4, s, v.z & 0xffffu); TR_ST(Vt, d0 + 5, s, v.z >> 16); TR_ST(Vt, d0 + 6, s, v.w & 0xffffu); TR_ST(Vt, d0 + 7, s, v.w >> 16);
        }
    }
    mlstm_gates_compute(fl, gv, b_i, b_f, h, tid);
    if (tid < 128) { wf[tid] = __expf(tot[0] - cf[tid] + igf[tid]); wb[tid] = __expf(cb[tid] + igb[tid]);
        if (tid == 0) { DEC[(c * 2 + 0) * 8 + h] = tot[0]; DEC[(c * 2 + 1) * 8 + h] = tot[1]; } }
    __syncthreads();
    bf16x8 vraw[4];
#pragma unroll
    for (int kk = 0; kk < 4; ++kk) vraw[kk] = TR_LD8(Vt, wid * 16 + fr, kk * 4 + fq);
#pragma unroll 1
    for (int dir = 0; dir < 2; ++dir) {
        const LAS float* w = dir ? wb : wf;
        f32x4 acc[8];
#pragma unroll
        for (int n = 0; n < 8; ++n) acc[n] = (f32x4){0.f, 0.f, 0.f, 0.f};
#pragma unroll
        for (int kk = 0; kk < 4; ++kk) {
            const f32x4 w0 = *(const LAS f32x4*)(w + kk * 32 + fq * 8), w1 = *(const LAS f32x4*)(w + kk * 32 + fq * 8 + 4);
            float vf[8]; unpack8(__builtin_bit_cast(u32x4, vraw[kk]), vf);
            u32x4 aw; aw.x = pk2(vf[0] * w0[0], vf[1] * w0[1]); aw.y = pk2(vf[2] * w0[2], vf[3] * w0[3]); aw.z = pk2(vf[4] * w1[0], vf[5] * w1[1]); aw.w = pk2(vf[6] * w1[2], vf[7] * w1[3]);
            const bf16x8 a = __builtin_bit_cast(bf16x8, aw);
#pragma unroll
            for (int n = 0; n < 8; ++n) { const bf16x8 b = TR_LD8(Kt, n * 16 + fr, kk * 4 + fq); acc[n] = MFMA16(b, a, acc[n]); }
        }
        LAS unsigned char* vimg = (LAS unsigned char*)Vt;
        { LAS unsigned char* wrow = vimg + tr_piece(wid * 16 + fr, 0) + fq * 8;
#pragma unroll
          for (int n = 0; n < 8; ++n) { u32x2 ww; ww.x = pk2(acc[n][0], acc[n][1]); ww.y = pk2(acc[n][2], acc[n][3]); *(LAS u32x2*)(wrow + n * 32) = ww; } }
        asm volatile("s_waitcnt lgkmcnt(0)" ::: "memory");
        u32x4* out = (u32x4*)(ST + (size_t)((c * 2 + dir) * 8 + h) * 16384 + wid * 16 * 128);
#pragma unroll
        for (int i = 0; i < 4; ++i) { const int q = lane + 64 * i; out[q] = *(const LAS u32x4*)(vimg + tr_piece(wid * 16 + (q >> 4), q & 15)); }
        asm volatile("s_waitcnt lgkmcnt(0)" ::: "memory");
    }
    {
        const int dir = tid >> 8, dk = (tid >> 1) & 127, hf = tid & 1; const LAS float* w = dir ? wb : wf; float sacc = 0.f;
#pragma unroll
        for (int j8 = 0; j8 < 8; ++j8) { const int j0 = hf * 64 + j8 * 8; float kf[8]; unpack8(__builtin_bit_cast(u32x4, TR_LD8(Kt, dk, j0 >> 3)), kf);
#pragma unroll
            for (int i = 0; i < 8; ++i) sacc += w[j0 + i] * kf[i]; }
        sacc += __shfl_xor(sacc, 1);
        if (hf == 0) NST[(size_t)((c * 2 + dir) * 8 + h) * 128 + dk] = sacc;
    }
    __syncthreads();
}
__device__ __forceinline__ void mlstm_scan(bf16_t* ST, float* NST, const float* DEC, int task) {
    if (task < 131072) {
        const int piece = task & 4095, chain = task >> 12, h = chain & 7, dir = (chain >> 3) & 1, seq = chain >> 4;
        const int clo = seq ? 64 : 0, chi = seq ? 192 : 64, nc = chi - clo;
        float run[4] = {0.f, 0.f, 0.f, 0.f};
#pragma unroll 8
        for (int i = 0; i < nc; ++i) {
            const int c = dir ? (chi - 1 - i) : (clo + i);
            u32x2* q = (u32x2*)(ST + (size_t)((c * 2 + dir) * 8 + h) * 16384 + piece * 4);
            const u32x2 lv = *q;
            const float dec = __expf(DEC[(c * 2 + dir) * 8 + h]);
            u32x2 o; o.x = pk2(run[0], run[1]); o.y = pk2(run[2], run[3]);
            *q = o;
            run[0] = dec * run[0] + bflo(lv.x); run[1] = dec * run[1] + bfhi(lv.x); run[2] = dec * run[2] + bflo(lv.y); run[3] = dec * run[3] + bfhi(lv.y);
        }
    } else if (task < 131072 + 4096) {
        const int t2 = task - 131072, dk = t2 & 127, chain = t2 >> 7, h = chain & 7, dir = (chain >> 3) & 1, seq = chain >> 4;
        const int clo = seq ? 64 : 0, chi = seq ? 192 : 64, nc = chi - clo;
        float run = 0.f;
#pragma unroll 8
        for (int i = 0; i < nc; ++i) {
            const int c = dir ? (chi - 1 - i) : (clo + i);
            float* q = NST + (size_t)((c * 2 + dir) * 8 + h) * 128 + dk;
            const float l = *q; const float dec = __expf(DEC[(c * 2 + dir) * 8 + h]);
            *q = run; run = dec * run + l;
        }
    }
}
template <int DIR>
__device__ __forceinline__ void mlstm_dir(const f32x4 (&S)[8], f32x4 (&acc)[8], f32x4 (&hs)[8], LAS bf16_t* Ps, const LAS bf16_t* Vt, const LAS float* fl, int wid, int fr, int fq) {
    const LAS float* ig = fl + (DIR ? 384 : 256); const LAS float* cc = fl + (DIR ? 640 : 512); const LAS float* tot = fl + 768; const LAS float* nq = fl + 1152;
    const int t = wid * 16 + fr;
    const float ct = cc[t], si = DIR ? __expf(tot[1] - ct) : __expf(ct);
    float rsum = 0.f;
#pragma unroll
    for (int n = 0; n < 8; ++n) {
        const int s4 = n * 16 + fq * 4;
        const f32x4 cs = *(const LAS f32x4*)(cc + s4), is = *(const LAS f32x4*)(ig + s4);
        float v[4];
#pragma unroll
        for (int jj = 0; jj < 4; ++jj) {
            const int s = s4 + jj;
            const bool ok = DIR ? (s >= t) : (s <= t);
            const float arg = DIR ? (cs[jj] - ct + is[jj]) : (ct - cs[jj] + is[jj]);
            v[jj] = ok ? S[n][jj] * __expf(arg) : 0.f;
            rsum += v[jj];
        }
        u32x2 w; w.x = pk2(v[0], v[1]); w.y = pk2(v[2], v[3]);
        *(LAS u32x2*)(Ps + t * LROW + s4) = w;
    }
    rsum += __shfl_xor(rsum, 16); rsum += __shfl_xor(rsum, 32);
    const float den = rsum + si * nq[DIR * 128 + t], scl = 1.f / fmaxf(fabsf(den), 1.f);
#pragma unroll
    for (int n = 0; n < 8; ++n) acc[n] *= si;
    asm volatile("s_waitcnt lgkmcnt(0)" ::: "memory");
#pragma unroll
    for (int kk = 0; kk < 4; ++kk) {
        const bf16x8 p = *(const LAS bf16x8*)(Ps + (wid * 16 + fr) * LROW + kk * 32 + fq * 8);
#pragma unroll
        for (int n = 0; n < 8; ++n) { const bf16x8 vf = TR_LD8(Vt, n * 16 + fr, kk * 4 + fq); acc[n] = MFMA16(vf, p, acc[n]); }
    }
#pragma unroll
    for (int n = 0; n < 8; ++n) hs[n] += acc[n] * scl;
    asm volatile("s_waitcnt lgkmcnt(0)" ::: "memory");
}
__device__ __forceinline__ void mlstm_passC(LAS unsigned char* lds, const bf16_t* Z, const float* G, const float* conv_w, const float* conv_b, const float* b_i, const float* b_f,
                                            const float* norm_w, const bf16_t* ST, const float* NST, bf16_t* MIX, int unit, int tid) {
    const int c = unit >> 3, h = unit & 7, r0 = c * 128;
    const int seq_lo = r0 < SEQ_P ? 0 : SEQ_P, seq_hi = r0 < SEQ_P ? SEQ_P : MROWS;
    LAS bf16_t* Qs = (LAS bf16_t*)lds; LAS bf16_t* Ks = Qs + 128 * LROW; LAS bf16_t* Vt = Ks + 128 * LROW; LAS bf16_t* Ps = Ks;
    LAS float* fl = (LAS float*)(lds + 104704);
    LAS float* nst = fl + 896  , *nq = fl + 1152  ;
    const int wid = tid >> 6, lane = tid & 63, fr = lane & 15, fq = lane >> 4;
    float gv[4]; mlstm_gates_load(G, r0, h, tid, gv);
    float nstv = 0.f; if (tid < 256) nstv = NST[(size_t)((c * 2 + (tid >> 7)) * 8 + h) * 128 + (tid & 127)];
    {
        const int d0 = (tid & 15) * 8, qcol = h * 128 + d0, kcol = 1024 + h * 128 + d0;
#pragma unroll 1
        for (int hb = 0; hb < 2; ++hb) {
        u32x4 q0[2], q1[2], q2[2], k0[2], k1[2], k2[2], vr[2];
#pragma unroll
        for (int it = 0; it < 2; ++it) { const int row = r0 + (tid >> 4) + 32 * (2 * hb + it);
            load3(Z, row, seq_lo, seq_hi, qcol, q0[it], q1[it], q2[it]); load3(Z, row, seq_lo, seq_hi, kcol, k0[it], k1[it], k2[it]);
            vr[it] = *(const u32x4*)(Z + (size_t)row * LDZ + 2048 + h * 128 + d0); }
        {   const ConvW cwq = load_convw(conv_w, conv_b, qcol);
#pragma unroll
            for (int it = 0; it < 2; ++it) { const int s = (tid >> 4) + 32 * (2 * hb + it);
                float qv[8]; conv8r(q0[it], q1[it], q2[it], cwq, 0.08838834764831845f, qv);
                u32x4 o; o.x = pk2(qv[0], qv[1]); o.y = pk2(qv[2], qv[3]); o.z = pk2(qv[4], qv[5]); o.w = pk2(qv[6], qv[7]);
                *(LAS u32x4*)(Qs + s * LROW + d0) = o; } }
        asm volatile("" ::: "memory");
        {   const ConvW cwk = load_convw(conv_w, conv_b, kcol);
#pragma unroll
            for (int it = 0; it < 2; ++it) { const int s = (tid >> 4) + 32 * (2 * hb + it);
                float kv[8]; conv8r(k0[it], k1[it], k2[it], cwk, 1.f, kv);
                u32x4 o; o.x = pk2(kv[0], kv[1]); o.y = pk2(kv[2], kv[3]); o.z = pk2(kv[4], kv[5]); o.w = pk2(kv[6], kv[7]);
                *(LAS u32x4*)(Ks + s * LROW + d0) = o; } }
#pragma unroll
        for (int it = 0; it < 2; ++it) { const int s = (tid >> 4) + 32 * (2 * hb + it); const u32x4 v = vr[it];
            TR_ST(Vt, d0 + 0, s, v.x & 0xffffu); TR_ST(Vt, d0 + 1, s, v.x >> 16); TR_ST(Vt, d0 + 2, s, v.y & 0xffffu); TR_ST(Vt, d0 + 3, s, v.y >> 16);
            TR_ST(Vt, d0 + 4, s, v.z & 0xffffu); TR_ST(Vt, d0 + 5, s, v.z >> 16); TR_ST(Vt, d0 + 6, s, v.w & 0xffffu); TR_ST(Vt, d0 + 7, s, v.w >> 16); }
        }
    }
    u32x4 cfr[4];
    { const u32x4* sf = (const u32x4*)(ST + (size_t)((c * 2 + 0) * 8 + h) * 16384) + tid;
#pragma unroll
      for (int i = 0; i < 4; ++i) cfr[i] = sf[512 * i]; }
    if (tid < 256) nst[tid] = nstv;
    mlstm_gates_compute(fl, gv, b_i, b_f, h, tid);
    LAS unsigned char* CF = lds + 110336;
#pragma unroll
    for (int i = 0; i < 4; ++i) { const int q = tid + 512 * i, e = q >> 4, pp = q & 15; *(LAS u32x4*)(CF + e * 256 + ((pp ^ (e & 15)) << 4)) = cfr[i]; }
    u32x4 cbr[4];
    { const u32x4* sb = (const u32x4*)(ST + (size_t)((c * 2 + 1) * 8 + h) * 16384) + tid;
#pragma unroll
      for (int i = 0; i < 4; ++i) cbr[i] = sb[512 * i]; }
    {
        const int t = tid >> 2, part = tid & 3; float sf = 0.f, sb = 0.f;
#pragma unroll
        for (int j8 = 0; j8 < 4; ++j8) { const int j0 = part * 32 + j8 * 8; float qf[8]; unpack8(*(const LAS u32x4*)(Qs + t * LROW + j0), qf);
#pragma unroll
            for (int i = 0; i < 8; ++i) { sf += qf[i] * nst[j0 + i]; sb += qf[i] * nst[128 + j0 + i]; } }
        sf += __shfl_xor(sf, 1); sf += __shfl_xor(sf, 2); sb += __shfl_xor(sb, 1); sb += __shfl_xor(sb, 2);
        if (part == 0) { nq[t] = sf; nq[128 + t] = sb; }
    }
    bf16x8 qa[4];
#pragma unroll
    for (int kk = 0; kk < 4; ++kk) qa[kk] = *(const LAS bf16x8*)(Qs + (wid * 16 + fr) * LROW + kk * 32 + fq * 8);
    f32x4 S[8];
#pragma unroll
    for (int n = 0; n < 8; ++n) S[n] = (f32x4){0.f, 0.f, 0.f, 0.f};
#pragma unroll
    for (int kk = 0; kk < 4; ++kk)
#pragma unroll
        for (int n = 0; n < 8; ++n) { const bf16x8 b = *(const LAS bf16x8*)(Ks + (n * 16 + fr) * LROW + kk * 32 + fq * 8); S[n] = MFMA16(b, qa[kk], S[n]); }
    __syncthreads();
    f32x4 hs[8];
#pragma unroll
    for (int n = 0; n < 8; ++n) hs[n] = (f32x4){0.f, 0.f, 0.f, 0.f};
    f32x4 Xf[8];
#pragma unroll
    for (int n = 0; n < 8; ++n) Xf[n] = (f32x4){0.f, 0.f, 0.f, 0.f};
#pragma unroll
    for (int kk = 0; kk < 4; ++kk)
#pragma unroll
        for (int n = 0; n < 8; ++n) { const bf16x8 b0 = *(const LAS bf16x8*)(CF + (n * 16 + fr) * 256 + (((kk * 4 + fq) ^ fr) << 4)); Xf[n] = MFMA16(b0, qa[kk], Xf[n]); }
    LAS unsigned char* CB = (LAS unsigned char*)Qs;
#pragma unroll
    for (int i = 0; i < 4; ++i) { const int q = tid + 512 * i, e = q >> 4, p = q & 15; *(LAS u32x4*)(CB + e * 256 + ((p ^ (e & 15)) << 4)) = cbr[i]; }
    u32x4 ogr[4];
#pragma unroll
    for (int i = 0; i < 4; ++i) { const int q = lane + 64 * i; ogr[i] = *(const u32x4*)(Z + (size_t)(r0 + wid * 16 + (q >> 4)) * LDZ + 3072 + h * 128 + (q & 15) * 8); }
    mlstm_dir<0>(S, Xf, hs, Ps, Vt, fl, wid, fr, fq);
    __syncthreads();
    f32x4 Xb[8];
#pragma unroll
    for (int n = 0; n < 8; ++n) Xb[n] = (f32x4){0.f, 0.f, 0.f, 0.f};
#pragma unroll
    for (int kk = 0; kk < 4; ++kk)
#pragma unroll
        for (int n = 0; n < 8; ++n) { const bf16x8 b1 = *(const LAS bf16x8*)(CB + (n * 16 + fr) * 256 + (((kk * 4 + fq) ^ fr) << 4)); Xb[n] = MFMA16(b1, qa[kk], Xb[n]); }
    mlstm_dir<1>(S, Xb, hs, Ps, Vt, fl, wid, fr, fq);
    {
        float s = 0.f;
#pragma unroll
        for (int n = 0; n < 8; ++n) s += (hs[n][0] + hs[n][1]) + (hs[n][2] + hs[n][3]);
        s += __shfl_xor(s, 16); s += __shfl_xor(s, 32);
        const float mu = s * (1.f / 128.f); float q = 0.f;
#pragma unroll
        for (int n = 0; n < 8; ++n) { const f32x4 d = hs[n] - mu; q += (d[0] * d[0] + d[1] * d[1]) + (d[2] * d[2] + d[3] * d[3]); }
        q += __shfl_xor(q, 16); q += __shfl_xor(q, 32);
        const float rstd = rsqrtf(q * (1.f / 128.f) + EPS);
        LAS unsigned char* wt = (LAS unsigned char*)Ps + (wid * 16) * (LROW * 2);
#pragma unroll
        for (int i = 0; i < 4; ++i) { const int q = lane + 64 * i; *(LAS u32x4*)(wt + (q >> 4) * (LROW * 2) + (q & 15) * 16) = ogr[i]; }
        asm volatile("s_waitcnt lgkmcnt(0)" ::: "memory");
        const float* nw = norm_w + h * 128 + fq * 4;
        LAS unsigned char* urow = wt + fr * (LROW * 2) + fq * 8;
#pragma unroll
        for (int n = 0; n < 8; ++n) {
            LAS u32x2* up = (LAS u32x2*)(urow + n * 32);
            const u32x2 og = *up; const f32x4 wv = *(const f32x4*)(nw + n * 16);
            const float o0 = (hs[n][0] - mu) * rstd * wv[0] * sigmoid_f(bflo(og.x)), o1 = (hs[n][1] - mu) * rstd * wv[1] * sigmoid_f(bfhi(og.x));
            const float o2 = (hs[n][2] - mu) * rstd * wv[2] * sigmoid_f(bflo(og.y)), o3 = (hs[n][3] - mu) * rstd * wv[3] * sigmoid_f(bfhi(og.y));
            u32x2 w; w.x = pk2(o0, o1); w.y = pk2(o2, o3); *up = w;
        }
        asm volatile("s_waitcnt lgkmcnt(0)" ::: "memory");
#pragma unroll
        for (int i = 0; i < 4; ++i) { const int q = lane + 64 * i, r = q >> 4, p = q & 15;
            *(u32x4*)(MIX + (size_t)(r0 + wid * 16 + r) * DM + h * 128 + p * 8) = *(const LAS u32x4*)(wt + r * (LROW * 2) + p * 16); }
    }
    __syncthreads();
}

#define XB_TMO      128
#define XB_XCNT(j)  (256  + 64 * (j))
#define XB_XSUB(j)  (1280 + 64 * (j))
#define XB_XGEN(j)  (2304 + 64 * (j))
#define XB_TOP      3328
#define XB_TOPGEN   3392
#define XCD_BAR_WORDS 3456
#define XB_SPIN_CAP (1u << 18)
__device__ __forceinline__ unsigned xb_ld(unsigned* p)              { return __hip_atomic_load(p, __ATOMIC_RELAXED, __HIP_MEMORY_SCOPE_AGENT); }
__device__ __forceinline__ unsigned xb_add(unsigned* p, unsigned v) { return __hip_atomic_fetch_add(p, v, __ATOMIC_RELAXED, __HIP_MEMORY_SCOPE_AGENT); }
__device__ __forceinline__ unsigned xb_xcc_id() { return (unsigned)__builtin_amdgcn_s_getreg((3 << 11) | 20) & 0xFu; }
#define XB_SPIN(cond, bar) do { unsigned _sp = 0; while (cond) { __builtin_amdgcn_s_sleep(1); \
    if ((++_sp & 255u) == 0u) { if (xb_ld(&(bar)[XB_TMO])) break; if (_sp > XB_SPIN_CAP) { atomicAdd(&(bar)[XB_TMO], 1u); break; } } } } while (0)
struct XcdBarrier { unsigned* bar; unsigned x; volatile LAS unsigned* st; };
__device__ __forceinline__ XcdBarrier xcd_barrier_post(unsigned* bar, volatile LAS unsigned* st) {
    XcdBarrier b; b.bar = bar; b.x = xb_xcc_id(); b.st = st;
    if (threadIdx.x == 0) (void)xb_add(&bar[XB_XCNT(b.x)], 1u);
    return b;
}
__device__ __forceinline__ void xcd_barrier_complete(unsigned* bar, unsigned x, unsigned& nloc, unsigned& nx) {
    const unsigned G = gridDim.x * gridDim.y * gridDim.z;
    unsigned sum, cnt, mine, sp = 0u;
    for (;;) {
        sum = 0u; cnt = 0u; mine = 0u;
#pragma unroll
        for (unsigned j = 0; j < 16; ++j) { const unsigned c = xb_ld(&bar[XB_XCNT(j)]); sum += c; cnt += (c > 0u) ? 1u : 0u; mine = (j == x) ? c : mine; }
        if (sum == G) break;
        __builtin_amdgcn_s_sleep(1);
        if ((++sp & 255u) == 0u) { if (xb_ld(&bar[XB_TMO])) break; if (sp > XB_SPIN_CAP) { atomicAdd(&bar[XB_TMO], 1u); break; } }
    }
    nloc = mine > 0u ? mine : 1u; nx = cnt > 0u ? cnt : 1u;
}
__device__ __forceinline__ void xcd_barrier(const XcdBarrier& b) {
    asm volatile("s_waitcnt vmcnt(0)" ::: "memory");
    __syncthreads();
    if (threadIdx.x == 0) {
        unsigned* bar = b.bar;
        __builtin_amdgcn_s_waitcnt(0);
        unsigned nloc = b.st[0], nx = b.st[1];
        if (nloc == 0u) { xcd_barrier_complete(bar, b.x, nloc, nx); b.st[0] = nloc; b.st[1] = nx; }
        const unsigned old = xb_add(&bar[XB_XSUB(b.x)], 1u);
        const unsigned gen = old / nloc;
        if (old + 1u == (gen + 1u) * nloc) {
            __builtin_amdgcn_fence(__ATOMIC_RELEASE, "agent");
            asm volatile("s_waitcnt vmcnt(0)" ::: "memory");
            const unsigned og = xb_add(&bar[XB_TOP], 1u);
            const unsigned tg = og / nx;
            if (og + 1u == (tg + 1u) * nx) xb_add(&bar[XB_TOPGEN], 1u);
            else XB_SPIN(xb_ld(&bar[XB_TOPGEN]) == tg, bar);
            __builtin_amdgcn_fence(__ATOMIC_ACQUIRE, "agent");
            xb_add(&bar[XB_XGEN(b.x)], 1u);
            asm volatile("s_waitcnt vmcnt(0)" ::: "memory");
        } else {
            XB_SPIN(xb_ld(&bar[XB_XGEN(b.x)]) == gen, bar);
            __builtin_amdgcn_fence(__ATOMIC_ACQUIRE, "agent");
            asm volatile("s_waitcnt vmcnt(0)" ::: "memory");
        }
    }
    __syncthreads();
}

#define PACK12(a,b,c,d,e,f,g,h,i,j,k,l) ((unsigned long long)(a) | ((unsigned long long)(b) << 5) | ((unsigned long long)(c) << 10) | ((unsigned long long)(d) << 15) | ((unsigned long long)(e) << 20) | ((unsigned long long)(f) << 25) | ((unsigned long long)(g) << 30) | ((unsigned long long)(h) << 35) | ((unsigned long long)(i) << 40) | ((unsigned long long)(j) << 45) | ((unsigned long long)(k) << 50) | ((unsigned long long)(l) << 55))
struct Args { const float* in[28]; float* out; unsigned char* ws; int ph_lo, ph_hi; };
constexpr int N_PHASES = 17;

__device__ __forceinline__ unsigned char* mkptr(volatile LAS unsigned* ptab, int k) {
    const unsigned long long v = ((unsigned long long)(unsigned)__builtin_amdgcn_readfirstlane((int)ptab[2 * k + 1]) << 32) | (unsigned long long)(unsigned)__builtin_amdgcn_readfirstlane((int)ptab[2 * k]);
    __attribute__((address_space(1))) unsigned char* g = (__attribute__((address_space(1))) unsigned char*)v;
    return (unsigned char*)g;
}
#define PTR(k) mkptr(ptab, (k))
#define INP(k) ((const float*)PTR(k))
#define OUTP ((float*)PTR(28))
#define WSP(off) (PTR(29) + (off))
template <int K>
__device__ __forceinline__ void run_phase(LAS unsigned char* lds, volatile LAS unsigned* ptab) {
    int tid_ = threadIdx.x; asm volatile("" : "+v"(tid_));
    const int tid = tid_, lane = tid & 63, wave = __builtin_amdgcn_readfirstlane(tid >> 6);
    const int G = gridDim.x, bx = blockIdx.x;
    const int gw = bx * 8 + wave, NGW = G * 8;
    if constexpr (K == 0) {
        convert_ffn(INP(3), INP(4), INP(5), (bf16_t*)WSP(WS_WAGU), (bf16_t*)WSP(WS_WAD), gw, NGW, lane);
        {
            const int nwg1 = (MROWS / 256) * (2 * DFF / 256), nidle = ((nwg1 + G - 1) / G) * G - nwg1;
            if (nidle == 0) convert_small(INP(7), INP(21), INP(22), (bf16_t*)WSP(WS_WIN), (bf16_t*)WSP(WS_WGLU), (bf16_t*)WSP(WS_WOUT), gw, NGW, lane);
        }
        bf16_t* Win_t = (bf16_t*)WSP(WS_WIN);
        for (int i = bx * 512 + tid; i < (NZ - D_IN) * DM / 8; i += G * 512) ((u32x4*)(Win_t + (size_t)D_IN * DM))[i] = (u32x4){0u, 0u, 0u, 0u};
        rms_rows_bf16(INP(0), INP(1), INP(2), (bf16_t*)WSP(WS_XN), gw, NGW, lane);
    }
    if constexpr (K == 1) {
        pg8::Gemm g{(const bf16_t*)WSP(WS_XN), (const bf16_t*)WSP(WS_WAGU), MROWS, 2 * DFF, DM, DM}; pg8::StaticOrder S; S.init(MROWS, 2 * DFF, G, bx);
        pg8::EpiSwiglu E{(bf16_t*)WSP(WS_BIG), DFF, 0, nullptr};
        pg8::gemm_phase<pg8::EpiSwiglu, true>(lds, g, S, E);
        {
            const int nwg1 = (MROWS / 256) * (2 * DFF / 256), nidle = ((nwg1 + G - 1) / G) * G - nwg1, first_idle = G - nidle;
            if (nidle > 0 && bx >= first_idle)
                convert_small(INP(7), INP(21), INP(22), (bf16_t*)WSP(WS_WIN), (bf16_t*)WSP(WS_WGLU), (bf16_t*)WSP(WS_WOUT), (bx - first_idle) * 8 + wave, nidle * 8, lane);
        }
    }
    if constexpr (K == 2) {
        for (int u = bx; u < 256; u += G)
            s5_gen(lds, INP(13), INP(14), INP(15), INP(16), INP(17), INP(18), INP(19), INP(20),
                   (bf16_t*)WSP(WS_S5W1) + (size_t)(u >> 2) * 256 * 512, (bf16_t*)WSP(WS_S5W3) + (size_t)(u >> 2) * 512 * 768, u >> 2, u & 3, tid);
        pg8::Gemm g{(const bf16_t*)WSP(WS_BIG), (const bf16_t*)WSP(WS_WAD), MROWS, DM, DFF, DFF}; pg8::StaticOrder S; S.init(MROWS, DM, G, bx);
        pg8::EpiResid E{INP(0), INP(1), OUTP, DM, 0.5f, (bf16_t*)WSP(WS_XN), INP(6), (float*)WSP(WS_SS1)};
        pg8::gemm_phase<pg8::EpiResid, true>(lds, g, S, E);
    }
    if constexpr (K == 4) {
        pg8::Gemm g{(const bf16_t*)WSP(WS_XN), (const bf16_t*)WSP(WS_WIN), MROWS, NZ, DM, DM}; pg8::StaticOrder S; S.init(MROWS, NZ, G, bx);
        pg8::EpiZ E{(bf16_t*)WSP(WS_BIG), LDZ, (float*)WSP(WS_GATES), 20, (const float*)WSP(WS_SS1), (bf16_t*)WSP(WS_UG)};
        pg8::gemm_phase<pg8::EpiZ, true>(lds, g, S, E);
    }
    if constexpr (K == 5) { const bf16_t* Z = (const bf16_t*)WSP(WS_UG); const bf16_t* W1 = (const bf16_t*)WSP(WS_S5W1); float* E = (float*)WSP(WS_S5E);
        for (int u = bx; u < 64 * 3 * 4; u += G) s5_egemm(lds, Z, W1, E, u, tid); }
    if constexpr (K == 6) { float* E = (float*)WSP(WS_S5E); const float* are = INP(13); const float* aim = INP(14); const float* ldt = INP(15);
        for (int t = bx * 512 + tid; t < 16384; t += G * 512) s5_scan(E, are, aim, ldt, t); }
    if constexpr (K == 7) { const bf16_t* Z = (const bf16_t*)WSP(WS_UG); const bf16_t* W3 = (const bf16_t*)WSP(WS_S5W3); const float* E = (const float*)WSP(WS_S5E); bf16_t* YG = (bf16_t*)WSP(WS_XN);
        for (int u = bx; u < 64 * 3 * 4; u += G) s5_ygemm(lds, Z, W3, E, YG, u, tid); }
    if constexpr (K == 8) {
        bf16_t* XN = (bf16_t*)WSP(WS_XN);
        pg8::Gemm g{XN, (const bf16_t*)WSP(WS_WGLU), MROWS, DM, DMH, DM}; pg8::StaticOrder S; S.init(MROWS, DM, G, bx);
        pg8::EpiSwiglu E{XN + DMH, DM, 1, nullptr};
        pg8::gemm_phase<pg8::EpiSwiglu, true>(lds, g, S, E);
    }
    if constexpr (K == 9) { const bf16_t* Z = (const bf16_t*)WSP(WS_BIG); const float* GA = (const float*)WSP(WS_GATES); bf16_t* ST = (bf16_t*)WSP(WS_ST); float* NST = (float*)WSP(WS_NST); float* DEC = (float*)WSP(WS_DEC);
        const float* cw = INP(8); const float* cb = INP(9); const float* bi = INP(10); const float* bf = INP(11);
        for (int u = bx; u < NCH * 8; u += G) mlstm_passA(lds, Z, GA, cw, cb, bi, bf, ST, NST, DEC, u, tid); }
    if constexpr (K == 10) { bf16_t* ST = (bf16_t*)WSP(WS_ST); float* NST = (float*)WSP(WS_NST); const float* DEC = (const float*)WSP(WS_DEC);
        for (int t = bx * 512 + tid; t < 131072 + 4096; t += G * 512) mlstm_scan(ST, NST, DEC, t); }
    if constexpr (K == 11) { const bf16_t* Z = (const bf16_t*)WSP(WS_BIG); const float* GA = (const float*)WSP(WS_GATES); const bf16_t* ST = (const bf16_t*)WSP(WS_ST); const float* NST = (const float*)WSP(WS_NST);
        const float* cw = INP(8); const float* cb = INP(9); const float* bi = INP(10); const float* bf = INP(11); const float* nw = INP(12); bf16_t* MIX = (bf16_t*)WSP(WS_XN);
        for (int u = bx; u < NCH * 8; u += G) mlstm_passC(lds, Z, GA, cw, cb, bi, bf, nw, ST, NST, MIX, u, tid); }
    if constexpr (K == 12) {
        float* out = OUTP;
        pg8::Gemm g{(const bf16_t*)WSP(WS_XN), (const bf16_t*)WSP(WS_WOUT), MROWS, DM, DM, DM}; pg8::StaticOrder S; S.init(MROWS, DM, G, bx);
        pg8::EpiResid E{out, out + (size_t)SEQ_P * DM, out, DM, 1.0f, (bf16_t*)WSP(WS_XN2), INP(23), (float*)WSP(WS_SS2)};
        pg8::gemm_phase<pg8::EpiResid, true>(lds, g, S, E);
    }
    if constexpr (K == 13) {
        const int nwg1 = (MROWS / 256) * (2 * DFF / 256), nidle = ((nwg1 + G - 1) / G) * G - nwg1;
        convert_ffn(INP(24), INP(25), INP(26), (bf16_t*)WSP(WS_WAGU2), (bf16_t*)WSP(WS_WAD2), gw, NGW, lane, nidle >= 64 ? 1 : 3);
    }
    if constexpr (K == 14) {
        pg8::Gemm g{(const bf16_t*)WSP(WS_XN2), (const bf16_t*)WSP(WS_WAGU2), MROWS, 2 * DFF, DM, DM}; pg8::StaticOrder S; S.init(MROWS, 2 * DFF, G, bx);
        pg8::EpiSwiglu E{(bf16_t*)WSP(WS_H2), DFF, 0, (const float*)WSP(WS_SS2)};
        pg8::gemm_phase<pg8::EpiSwiglu, true>(lds, g, S, E);
        {
            const int nwg1 = (MROWS / 256) * (2 * DFF / 256), nidle = ((nwg1 + G - 1) / G) * G - nwg1, first_idle = G - nidle;
            if (nidle >= 64 && bx >= first_idle)
                convert_ffn(INP(24), INP(25), INP(26), (bf16_t*)WSP(WS_WAGU2), (bf16_t*)WSP(WS_WAD2), (bx - first_idle) * 8 + wave, nidle * 8, lane, 2);
        }
    }
    if constexpr (K == 15) {
        float* out = OUTP;
        pg8::Gemm g{(const bf16_t*)WSP(WS_H2), (const bf16_t*)WSP(WS_WAD2), MROWS, DM, DFF, DFF}; pg8::StaticOrder S; S.init(MROWS, DM, G, bx);
        pg8::EpiResid E{out, out + (size_t)SEQ_P * DM, nullptr, DM, 0.5f, (bf16_t*)WSP(WS_XN2), INP(27), (float*)WSP(WS_SS3)};
        pg8::gemm_phase<pg8::EpiResid, true>(lds, g, S, E);
    }
    if constexpr (K == 16) final_scale_rows((const bf16_t*)WSP(WS_XN2), (const float*)WSP(WS_SS3), OUTP, gw, NGW, lane);
}

#ifndef PROBE
#define PROBE 0
#endif
__global__ void __launch_bounds__(512, 2) mega_fwd(Args args) {
    extern __shared__ __attribute__((aligned(16))) unsigned char lds_raw[];
    LAS unsigned char* lds = (LAS unsigned char*)lds_raw;
    cg::grid_group grid = cg::this_grid();
    volatile LAS unsigned* ptab = (volatile LAS unsigned*)(lds + 143360);
    if (threadIdx.x == 0) {
#pragma unroll
        for (int i = 0; i < 28; ++i) { const unsigned long long v = (unsigned long long)args.in[i]; ptab[2 * i] = (unsigned)v; ptab[2 * i + 1] = (unsigned)(v >> 32); }
        { const unsigned long long v = (unsigned long long)args.out; ptab[56] = (unsigned)v; ptab[57] = (unsigned)(v >> 32); }
        { const unsigned long long v = (unsigned long long)args.ws; ptab[58] = (unsigned)v; ptab[59] = (unsigned)(v >> 32); }
    }
    volatile LAS unsigned* bst = (volatile LAS unsigned*)(lds + 143360 + 256);
    if (threadIdx.x < 2) bst[threadIdx.x] = 0u;
    __syncthreads();
    XcdBarrier bar = xcd_barrier_post((unsigned*)args.ws + 4096, bst);
#define RUN(k) run_phase<k>(lds, ptab)
#define SYNC xcd_barrier(bar)
    RUN(0);
    if (args.ph_lo != 0) grid.sync();
    SYNC;
#if PROBE == 5
    RUN(0); SYNC;
#endif
    RUN(1); SYNC; RUN(2); SYNC; RUN(4); SYNC;
    RUN(5); SYNC; RUN(6); SYNC;
#if PROBE == 7
    RUN(5); SYNC; RUN(6); SYNC;
#endif
    RUN(7); SYNC;
#if PROBE == 1
    RUN(5); SYNC; RUN(6); SYNC; RUN(7); SYNC;
#endif
    RUN(8);
    RUN(9); SYNC; RUN(10); SYNC;
#if PROBE == 8
    RUN(9); SYNC; RUN(10); SYNC;
#endif
    RUN(11); SYNC;
#if PROBE == 2
    RUN(9); SYNC; RUN(10); SYNC; RUN(11); SYNC;
#endif
    RUN(12); SYNC; RUN(13); SYNC;
#if PROBE == 6
    RUN(13); SYNC;
#endif
    RUN(14); SYNC; RUN(15); SYNC; RUN(16);
}

extern "C" void kernel_launch(void* const* d_in, const int* in_sizes, int n_in, void* d_out, int out_size, void* d_ws, size_t ws_size, hipStream_t stream) {
    static int grid = 0;
    if (grid == 0) {
        if (n_in != 28 || out_size != MROWS * DM || ws_size < WS_END) { fprintf(stderr, "kernel_launch: unexpected shapes (n_in %d out %d ws %zu)\n", n_in, out_size, ws_size); grid = -1; return; }
        int dev = 0, cus = 0, per_cu = 0;
        (void)hipGetDevice(&dev); (void)hipDeviceGetAttribute(&cus, hipDeviceAttributeMultiprocessorCount, dev);
        if (hipFuncSetAttribute((const void*)mega_fwd, hipFuncAttributeMaxDynamicSharedMemorySize, LDS_BYTES) != hipSuccess) { fprintf(stderr, "kernel_launch: hipFuncSetAttribute failed\n"); grid = -1; return; }
        if (hipOccupancyMaxActiveBlocksPerMultiprocessor(&per_cu, (const void*)mega_fwd, 512, LDS_BYTES) != hipSuccess || per_cu < 1) { fprintf(stderr, "kernel_launch: occupancy query says %d\n", per_cu); per_cu = 1; }
        (void)hipGetLastError();
        grid = cus * 1;
        if (grid <= 0) grid = 256;
    }
    if (grid < 0) return;
    Args a{};
    for (int i = 0; i < 28; ++i) a.in[i] = (const float*)d_in[i];
    a.out = (float*)d_out; a.ws = (unsigned char*)d_ws; a.ph_lo = 0; a.ph_hi = 0;
    if (hipMemsetAsync(d_ws, 0, WS_ZERO_BYTES, stream) != hipSuccess) { fprintf(stderr, "kernel_launch: memset failed\n"); return; }
    void* kargs[] = {&a};
    hipError_t e = hipLaunchCooperativeKernel((const void*)mega_fwd, dim3(grid), dim3(512), kargs, LDS_BYTES, stream);
    if (e != hipSuccess) fprintf(stderr, "kernel_launch: cooperative launch failed: %s (grid %d)\n", hipGetErrorString(e), grid);
}
```
